# Optimizing an MI355X kernel written in HIP

```python
import math
import jax
import jax.numpy as jnp
from jax import lax

D_MODEL = 1024
BATCH = 2
SEQ = 16384
DEPTH = 4
DEC_BATCH = 8
DEC_SEQ = 16
PAST_LEN = 2048

CHUNK = 64
MIX_WIDTH = D_MODEL
CONV_W = 4
LRU_WIDTH = MIX_WIDTH // 4
LRU_BLOCKS = 4
LRU_BLOCK = LRU_WIDTH // LRU_BLOCKS
LRU_C = 8.0
SSD_WIDTH = MIX_WIDTH // 4
SSD_HEAD_DIM = 64
SSD_HEADS = SSD_WIDTH // SSD_HEAD_DIM
SSD_GROUPS = 2
SSD_STATE = 128
SSD_CONV_CH = SSD_WIDTH + 2 * SSD_GROUPS * SSD_STATE
SSD_CHUNK = CHUNK
ATT_WIDTH = MIX_WIDTH - LRU_WIDTH - SSD_WIDTH
ATT_HEADS = 4
ATT_V_DIM = ATT_WIDTH // ATT_HEADS
ATT_HEAD_DIM = ATT_V_DIM // 2
ATT_QK = ATT_HEADS * 2 * ATT_HEAD_DIM
ATT_SCALE = ATT_HEAD_DIM ** -0.5
Q_BLOCK = 128
D_FF = 4 * D_MODEL
EPS = 1e-6
IN_SEGMENTS = (LRU_WIDTH, LRU_WIDTH, SSD_WIDTH, SSD_CONV_CH, SSD_HEADS, ATT_QK, ATT_QK, ATT_WIDTH)
IN_COLS = sum(IN_SEGMENTS)
IN_SPLITS = tuple(sum(IN_SEGMENTS[:i + 1]) for i in range(len(IN_SEGMENTS) - 1))

kernel_name = "hymba_style_lru_ssd_diffattn_stream_step"


def rms_norm(x, g):
    xf = x.astype(jnp.float32)
    y = xf * lax.rsqrt(jnp.mean(xf * xf, axis=-1, keepdims=True) + EPS)
    return (y * g.astype(jnp.float32)).astype(x.dtype)


def causal_conv(x, prev, w, b):
    L = x.shape[1]
    xp = jnp.concatenate([prev.astype(x.dtype), x], axis=1)
    y = b.astype(x.dtype) + w[0] * xp[:, 0:L]
    for j in range(1, CONV_W):
        y = y + w[j] * xp[:, j:j + L]
    return y, xp[:, L:]


def rg_lru(x, h0, wa, ba, wx, bx, lam):
    bsz, L, W = x.shape
    xb = x.reshape(bsz, L, LRU_BLOCKS, LRU_BLOCK)
    r = jax.nn.sigmoid((jnp.einsum("blhi,hij->blhj", xb, wa).reshape(bsz, L, W) + ba).astype(jnp.float32))
    i = jax.nn.sigmoid((jnp.einsum("blhi,hij->blhj", xb, wx).reshape(bsz, L, W) + bx).astype(jnp.float32))
    log_a = -LRU_C * r * jax.nn.softplus(-lam.astype(jnp.float32))
    a = jnp.exp(log_a)
    b = jnp.sqrt(-jnp.expm1(2.0 * log_a)) * (i * x.astype(jnp.float32))
    b = b.at[:, 0].add(a[:, 0] * h0.astype(jnp.float32))

    def combine(left, right):
        a1, b1 = left
        a2, b2 = right
        return a1 * a2, a2 * b1 + b2

    _, h = lax.associative_scan(combine, (a, b), axis=1)
    return h.astype(x.dtype), h[:, -1].astype(x.dtype)


def ssd_scan(xs, dt, a_neg, bm, cm, h0):
    bsz, L, H, P = xs.shape
    T = min(SSD_CHUNK, L)
    nc = L // T
    rep = H // SSD_GROUPS
    bh = jnp.repeat(bm, rep, axis=2).reshape(bsz, nc, T, H, SSD_STATE).astype(jnp.float32)
    ch = jnp.repeat(cm, rep, axis=2).reshape(bsz, nc, T, H, SSD_STATE).astype(jnp.float32)
    x_c = xs.reshape(bsz, nc, T, H, P).astype(jnp.float32)
    dt_c = dt.reshape(bsz, nc, T, H)
    cs = jnp.cumsum(dt_c * a_neg, axis=2)
    seg = cs[:, :, :, None, :] - cs[:, :, None, :, :]
    causal = jnp.tril(jnp.ones((T, T), dtype=bool))[None, None, :, :, None]
    decay = jnp.exp(jnp.where(causal, seg, -jnp.inf))
    xdt = x_c * dt_c[..., None]
    scores = jnp.einsum("bcihn,bcjhn->bcijh", ch, bh) * decay
    y_intra = jnp.einsum("bcijh,bcjhp->bcihp", scores, xdt)
    tail = jnp.exp(cs[:, :, -1:, :] - cs)
    s_local = jnp.einsum("bcjh,bcjhn,bcjhp->bchpn", tail, bh, xdt)
    chunk_decay = jnp.exp(cs[:, :, -1, :])

    def step(h, inp):
        dec, s = inp
        return dec[..., None, None] * h + s, h

    h_last, h_starts = lax.scan(step, h0.astype(jnp.float32),
                                (jnp.moveaxis(chunk_decay, 1, 0), jnp.moveaxis(s_local, 1, 0)))
    h_starts = jnp.moveaxis(h_starts, 0, 1)
    y_inter = jnp.einsum("bcihn,bchpn,bcih->bcihp", ch, h_starts, jnp.exp(cs))
    y = (y_intra + y_inter).reshape(bsz, L, H, P)
    return y, h_last


def diff_attn_block(q, qpos, k, v, kpos, lam):
    s = jnp.einsum("bqhmd,bkhmd->bhmqk", q, k, preferred_element_type=jnp.float32) * ATT_SCALE
    mask = (kpos[None, :] // CHUNK) <= (qpos[:, None] // CHUNK)
    s = jnp.where(mask, s, -jnp.inf)
    p = jax.nn.softmax(s, axis=-1)
    w = p[:, :, 0] - lam * p[:, :, 1]
    return jnp.einsum("bhqk,bkhe->bqhe", w.astype(v.dtype), v)


def diff_attention(q, qpos, k, v, kpos, lam):
    bsz, L = q.shape[:2]
    if L <= Q_BLOCK:
        return diff_attn_block(q, qpos, k, v, kpos, lam)
    nb = L // Q_BLOCK
    qb = jnp.moveaxis(q.reshape(bsz, nb, Q_BLOCK, *q.shape[2:]), 1, 0)
    pb = qpos.reshape(nb, Q_BLOCK)
    ob = lax.map(lambda a: diff_attn_block(a[0], a[1], k, v, kpos, lam), (qb, pb))
    return jnp.moveaxis(ob, 0, 1).reshape(bsz, L, *ob.shape[3:])


def layer_step(x, p, lam_init, conv_lru0, h_lru0, conv_ssd0, h_ssd0, past_k, past_v):
    bsz, L, _ = x.shape
    adt = x.dtype
    xn = rms_norm(x, p["norm_mix_g"])
    proj = jnp.einsum("bld,dc->blc", xn, p["w_in"])
    gate_r, x_r, z, xbc, dt_raw, q, k, v = jnp.split(proj, IN_SPLITS, axis=-1)

    x_r, conv_lru = causal_conv(x_r, conv_lru0, p["lru_conv_w"], p["lru_conv_b"])
    h_seq, h_lru = rg_lru(x_r, h_lru0, p["lru_wa"], p["lru_ba"], p["lru_wx"], p["lru_bx"], p["lru_lambda"])
    y_lru = jax.nn.gelu(gate_r) * h_seq

    xbc_c, conv_ssd = causal_conv(xbc, conv_ssd0, p["ssd_conv_w"], p["ssd_conv_b"])
    xbc_c = jax.nn.silu(xbc_c)
    xs, bm, cm = jnp.split(xbc_c, (SSD_WIDTH, SSD_WIDTH + SSD_GROUPS * SSD_STATE), axis=-1)
    xs = xs.reshape(bsz, L, SSD_HEADS, SSD_HEAD_DIM)
    bm = bm.reshape(bsz, L, SSD_GROUPS, SSD_STATE)
    cm = cm.reshape(bsz, L, SSD_GROUPS, SSD_STATE)
    dt = jax.nn.softplus(dt_raw.astype(jnp.float32) + p["ssd_dt_bias"].astype(jnp.float32))
    a_neg = -jnp.exp(p["ssd_a_log"].astype(jnp.float32))
    y_ssd, h_ssd = ssd_scan(xs, dt, a_neg, bm, cm, h_ssd0)
    y_ssd = y_ssd + p["ssd_d"].astype(jnp.float32)[:, None] * xs.astype(jnp.float32)
    y_ssd = y_ssd.reshape(bsz, L, SSD_WIDTH) * jax.nn.silu(z.astype(jnp.float32))
    y_ssd = rms_norm(y_ssd.reshape(bsz, L, SSD_GROUPS, SSD_WIDTH // SSD_GROUPS),
                     p["ssd_norm_g"].reshape(SSD_GROUPS, SSD_WIDTH // SSD_GROUPS))
    y_ssd = y_ssd.reshape(bsz, L, SSD_WIDTH).astype(adt)

    q = q.reshape(bsz, L, ATT_HEADS, 2, ATT_HEAD_DIM)
    k_rows = k.reshape(bsz, L, ATT_HEADS, ATT_V_DIM)
    v_rows = v.reshape(bsz, L, ATT_HEADS, ATT_V_DIM)
    if past_k is None:
        past_len = 0
        k_all, v_all = k_rows, v_rows
    else:
        past_len = past_k.shape[1]
        k_all = jnp.concatenate([past_k.astype(adt), k_rows], axis=1)
        v_all = jnp.concatenate([past_v.astype(adt), v_rows], axis=1)
    n_keys = k_all.shape[1]
    qpos = past_len + jnp.arange(L)
    kpos = jnp.arange(n_keys)
    lv = p["att_lambda"].astype(jnp.float32)
    lam = jnp.exp(jnp.sum(lv[0] * lv[1])) - jnp.exp(jnp.sum(lv[2] * lv[3])) + lam_init
    o = diff_attention(q, qpos, k_all.reshape(bsz, n_keys, ATT_HEADS, 2, ATT_HEAD_DIM), v_all, kpos, lam)
    o = rms_norm(o, p["att_subln_g"]) * (1.0 - lam_init)
    y_att = o.reshape(bsz, L, ATT_WIDTH).astype(adt)

    mixed = jnp.concatenate([y_lru, y_ssd, y_att], axis=-1)
    x = x + jnp.einsum("blc,cd->bld", mixed, p["w_out"])

    hn = rms_norm(x, p["norm_ffn_g"])
    u = jnp.square(jax.nn.relu(jnp.einsum("bld,df->blf", hn, p["w_up"])))
    x = x + jnp.einsum("blf,fd->bld", u, p["w_down"])
    return x, (k_rows, v_rows, conv_lru, h_lru, conv_ssd, h_ssd)


def setup_inputs(seed: int = 0) -> dict:
    key = jax.random.key(seed)
    ks = iter(jax.random.split(key, 40))

    def nrm(shape, scale):
        return scale * jax.random.normal(next(ks), shape, jnp.float32)

    def uni(shape, lo, hi):
        return jax.random.uniform(next(ks), shape, jnp.float32, minval=lo, maxval=hi)

    x_prompt = nrm((BATCH, SEQ, D_MODEL), 1.0)
    x_sample = nrm((DEC_BATCH, DEC_SEQ, D_MODEL), 1.0)
    cache_att_k = nrm((DEPTH, DEC_BATCH, PAST_LEN, ATT_HEADS, ATT_V_DIM), 1.0)
    cache_att_v = nrm((DEPTH, DEC_BATCH, PAST_LEN, ATT_HEADS, ATT_V_DIM), 1.0)
    state_lru_conv = nrm((DEPTH, DEC_BATCH, CONV_W - 1, LRU_WIDTH), 1.0)
    state_lru_h = nrm((DEPTH, DEC_BATCH, LRU_WIDTH), 0.5)
    state_ssd_conv = nrm((DEPTH, DEC_BATCH, CONV_W - 1, SSD_CONV_CH), 1.0)
    state_ssd_h = nrm((DEPTH, DEC_BATCH, SSD_HEADS, SSD_HEAD_DIM, SSD_STATE), 0.1)

    norm_mix_g = 1.0 + nrm((DEPTH, D_MODEL), 0.02)
    w_in = nrm((DEPTH, D_MODEL, IN_COLS), D_MODEL ** -0.5)
    lru_conv_w = nrm((DEPTH, CONV_W, LRU_WIDTH), CONV_W ** -0.5)
    lru_conv_b = nrm((DEPTH, LRU_WIDTH), 0.02)
    lru_wa = nrm((DEPTH, LRU_BLOCKS, LRU_BLOCK, LRU_BLOCK), LRU_BLOCK ** -0.5)
    lru_ba = nrm((DEPTH, LRU_WIDTH), 0.02)
    lru_wx = nrm((DEPTH, LRU_BLOCKS, LRU_BLOCK, LRU_BLOCK), LRU_BLOCK ** -0.5)
    lru_bx = nrm((DEPTH, LRU_WIDTH), 0.02)
    a8 = uni((DEPTH, LRU_WIDTH), 0.9, 0.999)
    s_lam = a8 ** (1.0 / LRU_C)
    lru_lambda = jnp.log(s_lam) - jnp.log1p(-s_lam)
    ssd_conv_w = nrm((DEPTH, CONV_W, SSD_CONV_CH), CONV_W ** -0.5)
    ssd_conv_b = nrm((DEPTH, SSD_CONV_CH), 0.02)
    dt0 = jnp.exp(uni((DEPTH, SSD_HEADS), math.log(1e-3), math.log(1e-1)))
    ssd_dt_bias = dt0 + jnp.log(-jnp.expm1(-dt0))
    ssd_a_log = jnp.log(uni((DEPTH, SSD_HEADS), 1.0, 16.0))
    ssd_d = 1.0 + nrm((DEPTH, SSD_HEADS), 0.1)
    ssd_norm_g = 1.0 + nrm((DEPTH, SSD_WIDTH), 0.02)
    att_lambda = nrm((DEPTH, 4, ATT_HEAD_DIM), 0.1)
    att_subln_g = 1.0 + nrm((DEPTH, ATT_V_DIM), 0.02)
    w_out = nrm((DEPTH, MIX_WIDTH, D_MODEL), MIX_WIDTH ** -0.5)
    norm_ffn_g = 1.0 + nrm((DEPTH, D_MODEL), 0.02)
    w_up = nrm((DEPTH, D_MODEL, D_FF), D_MODEL ** -0.5)
    w_down = nrm((DEPTH, D_FF, D_MODEL), D_FF ** -0.5)
    norm_f_g = 1.0 + nrm((D_MODEL,), 0.02)
    return {
        "x_prompt": x_prompt, "x_sample": x_sample,
        "cache_att_k": cache_att_k, "cache_att_v": cache_att_v,
        "state_lru_conv": state_lru_conv, "state_lru_h": state_lru_h,
        "state_ssd_conv": state_ssd_conv, "state_ssd_h": state_ssd_h,
        "norm_mix_g": norm_mix_g, "w_in": w_in,
        "lru_conv_w": lru_conv_w, "lru_conv_b": lru_conv_b,
        "lru_wa": lru_wa, "lru_ba": lru_ba, "lru_wx": lru_wx, "lru_bx": lru_bx,
        "lru_lambda": lru_lambda,
        "ssd_conv_w": ssd_conv_w, "ssd_conv_b": ssd_conv_b, "ssd_dt_bias": ssd_dt_bias,
        "ssd_a_log": ssd_a_log, "ssd_d": ssd_d, "ssd_norm_g": ssd_norm_g,
        "att_lambda": att_lambda, "att_subln_g": att_subln_g,
        "w_out": w_out, "norm_ffn_g": norm_ffn_g, "w_up": w_up, "w_down": w_down,
        "norm_f_g": norm_f_g,
    }


def reference(x_prompt, x_sample, cache_att_k, cache_att_v, state_lru_conv, state_lru_h,
              state_ssd_conv, state_ssd_h, norm_mix_g, w_in, lru_conv_w, lru_conv_b,
              lru_wa, lru_ba, lru_wx, lru_bx, lru_lambda, ssd_conv_w, ssd_conv_b,
              ssd_dt_bias, ssd_a_log, ssd_d, ssd_norm_g, att_lambda, att_subln_g,
              w_out, norm_ffn_g, w_up, w_down, norm_f_g):
    xp = x_prompt
    xs = x_sample
    bp = xp.shape[0]
    zero_lru_conv = jnp.zeros((bp, CONV_W - 1, LRU_WIDTH), xp.dtype)
    zero_lru_h = jnp.zeros((bp, LRU_WIDTH), xp.dtype)
    zero_ssd_conv = jnp.zeros((bp, CONV_W - 1, SSD_CONV_CH), xp.dtype)
    zero_ssd_h = jnp.zeros((bp, SSD_HEADS, SSD_HEAD_DIM, SSD_STATE), xp.dtype)
    st_p_all = []
    st_s_all = []
    for l in range(DEPTH):
        p = {
            "norm_mix_g": norm_mix_g[l], "w_in": w_in[l],
            "lru_conv_w": lru_conv_w[l], "lru_conv_b": lru_conv_b[l],
            "lru_wa": lru_wa[l], "lru_ba": lru_ba[l], "lru_wx": lru_wx[l], "lru_bx": lru_bx[l],
            "lru_lambda": lru_lambda[l],
            "ssd_conv_w": ssd_conv_w[l], "ssd_conv_b": ssd_conv_b[l],
            "ssd_dt_bias": ssd_dt_bias[l], "ssd_a_log": ssd_a_log[l], "ssd_d": ssd_d[l],
            "ssd_norm_g": ssd_norm_g[l],
            "att_lambda": att_lambda[l], "att_subln_g": att_subln_g[l],
            "w_out": w_out[l], "norm_ffn_g": norm_ffn_g[l], "w_up": w_up[l], "w_down": w_down[l],
        }
        lam_init = 0.8 - 0.6 * math.exp(-0.3 * l)
        xp, st_p = layer_step(xp, p, lam_init, zero_lru_conv, zero_lru_h, zero_ssd_conv, zero_ssd_h,
                              None, None)
        xs, st_s = layer_step(xs, p, lam_init, state_lru_conv[l], state_lru_h[l], state_ssd_conv[l],
                              state_ssd_h[l], cache_att_k[l], cache_att_v[l])
        st_p_all.append(st_p)
        st_s_all.append(st_s)

    def stack(sts, i):
        return jnp.stack([s[i] for s in sts], axis=0)

    y_prompt = rms_norm(xp, norm_f_g)
    y_sample = rms_norm(xs, norm_f_g)
    new_k_p = stack(st_p_all, 0)
    new_v_p = stack(st_p_all, 1)
    lru_conv_p = stack(st_p_all, 2)
    lru_h_p = stack(st_p_all, 3)
    ssd_conv_p = stack(st_p_all, 4)
    ssd_h_p = stack(st_p_all, 5)
    new_k_s = stack(st_s_all, 0)
    new_v_s = stack(st_s_all, 1)
    lru_conv_s = stack(st_s_all, 2)
    lru_h_s = stack(st_s_all, 3)
    ssd_conv_s = stack(st_s_all, 4)
    ssd_h_s = stack(st_s_all, 5)
    return (y_prompt, y_sample, new_k_p, new_v_p, lru_conv_p, lru_h_p, ssd_conv_p, ssd_h_p,
            new_k_s, new_v_s, lru_conv_s, lru_h_s, ssd_conv_s, ssd_h_s)
```

```cpp
#include <hip/hip_runtime.h>
#include <hip/hip_cooperative_groups.h>
#include <stdint.h>
#include <stdio.h>
#include <string.h>
#include <math.h>
namespace cg = cooperative_groups;

typedef unsigned short bf16_t;
typedef short bf16x8 __attribute__((ext_vector_type(8)));
typedef short s16x4 __attribute__((ext_vector_type(4)));
typedef float f32x16 __attribute__((ext_vector_type(16)));
typedef float f32x4 __attribute__((ext_vector_type(4)));
typedef unsigned u32x4 __attribute__((ext_vector_type(4)));
typedef unsigned u32x2 __attribute__((ext_vector_type(2)));
typedef float f32x2 __attribute__((ext_vector_type(2)));
#define DEV __device__ __forceinline__
#define LAS __attribute__((address_space(3)))

constexpr int TP = 32768, TS = 128, MTOK = TP + TS;
constexpr int DM = 1024, DFF = 4096, DEPTH = 4;
constexpr int PW = 3072;
constexpr int NIN = 3328;
constexpr int C_GATE = 0, C_XR = 256, C_Z = 512, C_XBC = 768, C_Q = 1536, C_K = 2048, C_V = 2560;
constexpr int NPART = 8;
constexpr float EPS = 1e-6f;

constexpr size_t O_YP = 0;
constexpr size_t O_YS = O_YP + (size_t)TP * DM;
constexpr size_t O_KP = O_YS + (size_t)TS * DM;
constexpr size_t O_VP = O_KP + (size_t)DEPTH * TP * 512;
constexpr size_t O_LCP = O_VP + (size_t)DEPTH * TP * 512;
constexpr size_t O_LHP = O_LCP + (size_t)DEPTH * 2 * 3 * 256;
constexpr size_t O_SCP = O_LHP + (size_t)DEPTH * 2 * 256;
constexpr size_t O_SHP = O_SCP + (size_t)DEPTH * 2 * 3 * 768;
constexpr size_t O_KS = O_SHP + (size_t)DEPTH * 2 * 4 * 64 * 128;
constexpr size_t O_VS = O_KS + (size_t)DEPTH * TS * 512;
constexpr size_t O_LCS = O_VS + (size_t)DEPTH * TS * 512;
constexpr size_t O_LHS = O_LCS + (size_t)DEPTH * 8 * 3 * 256;
constexpr size_t O_SCS = O_LHS + (size_t)DEPTH * 8 * 256;
constexpr size_t O_SHS = O_SCS + (size_t)DEPTH * 8 * 3 * 768;

constexpr size_t AL(size_t x) { return (x + 255) & ~(size_t)255; }
constexpr size_t W_CTR = 0;
constexpr size_t W_WTIN = 4096;
constexpr size_t W_WTOUT = W_WTIN + AL((size_t)DEPTH * NIN * DM * 2);
constexpr size_t W_WTUP = W_WTOUT + AL((size_t)DEPTH * DM * DM * 2);
constexpr size_t W_WTDN = W_WTUP + AL((size_t)DEPTH * DFF * DM * 2);
constexpr size_t W_WAT = W_WTDN + AL((size_t)DEPTH * DFF * DM * 2);
constexpr size_t W_WXT = W_WAT + AL((size_t)DEPTH * 4 * 64 * 64 * 2);
constexpr size_t W_XBF = W_WXT + AL((size_t)DEPTH * 4 * 64 * 64 * 2);
constexpr size_t W_SSQ = W_XBF + AL((size_t)MTOK * DM * 2);
constexpr size_t W_SSDS = W_SSQ + AL((size_t)MTOK * NPART * 4);
constexpr size_t W_SSDDEC = W_SSDS + AL((size_t)2 * 256 * 4 * 64 * 128 * 2);
constexpr size_t W_LRUA = W_SSDDEC + AL((size_t)2 * 256 * 4 * 4);
constexpr size_t W_LRUB = W_LRUA + AL((size_t)2 * 256 * 256 * 4);
constexpr size_t W_PROJ = W_LRUB + AL((size_t)2 * 256 * 256 * 4);
constexpr size_t W_DTRAW = W_PROJ + AL((size_t)MTOK * PW * 2);
constexpr size_t W_KC = W_DTRAW + AL((size_t)MTOK * 4 * 4);
constexpr size_t W_VC = W_KC + AL((size_t)8 * 2048 * 512 * 2);
constexpr size_t W_MIX = W_VC + AL((size_t)8 * 2048 * 512 * 2);
constexpr size_t W_END = W_MIX + AL((size_t)MTOK * DM * 2);
constexpr size_t W_LHL = W_END;
constexpr size_t W_LCA = W_LHL + AL((size_t)MTOK * 256 * 2);
constexpr size_t W_END2 = W_LCA + AL((size_t)MTOK * 256 * 2);
constexpr size_t W_U = W_PROJ;
static_assert(W_U + (size_t)MTOK * DFF * 2 <= W_END, "U overlay");

constexpr int LDS_BYTES = 155 * 1024;
#ifndef PROBE_ATT
#define PROBE_ATT 1
#endif
#ifndef PROBE_GEMM
#define PROBE_GEMM 1
#endif
#ifndef PROBE_CHUNK
#define PROBE_CHUNK 1
#endif

struct Params {
  const float* in[30];
  float* out;
  char* ws;
};
typedef const __attribute__((address_space(4))) Params CParams;

typedef __bf16 bf16v2 __attribute__((ext_vector_type(2)));
DEV uint32_t pk2(float lo, float hi) { f32x2 v; v[0] = lo; v[1] = hi; bf16v2 b = __builtin_convertvector(v, bf16v2); return __builtin_bit_cast(uint32_t, b); }
DEV float bflo(uint32_t u) { return __uint_as_float(u << 16); }
DEV float bfhi(uint32_t u) { return __uint_as_float(u & 0xffff0000u); }
DEV float bf2f(bf16_t b) { return __uint_as_float((uint32_t)b << 16); }
DEV bf16_t f2bf(float f) { return (bf16_t)(pk2(f, 0.f) & 0xffffu); }
DEV float fexp(float x) { return __builtin_amdgcn_exp2f(x * 1.4426950408889634f); }
DEV float flog(float x) { return __builtin_amdgcn_logf(x) * 0.6931471805599453f; }
DEV float frcp(float x) { return __builtin_amdgcn_rcpf(x); }
DEV float sigmoidf_(float x) { return frcp(1.f + fexp(-x)); }
DEV float siluf_(float x) { return x * frcp(1.f + fexp(-x)); }
DEV float softplusf_(float x) { return x > 20.f ? x : flog(1.f + fexp(x)); }
DEV float geluf_(float x) { const float u = 0.7978845608028654f * (x + 0.044715f * x * x * x); const float t = 1.f - 2.f * frcp(1.f + fexp(2.f * u)); return 0.5f * x * (1.f + t); }
DEV float neg_expm1(float y) { return y > -0.05f ? -y * (1.f + y * (0.5f + y * (0.16666667f + y * 0.041666668f))) : 1.f - fexp(y); }
DEV f32x16 mfma32(bf16x8 a, bf16x8 b, f32x16 c) { return __builtin_amdgcn_mfma_f32_32x32x16_bf16(a, b, c, 0, 0, 0); }
DEV f32x16 zero16() { float zz = 0.f; asm volatile("" : "+v"(zz)); f32x16 z; for (int i = 0; i < 16; ++i) z[i] = zz; return z; }
DEV bf16x8 lds_read8(const char* p) { return *(const bf16x8*)p; }
DEV bf16x8 tr8(const char* base, int stride, int r0, int c0, int lane) {
  const int gi = lane >> 4, q = (lane & 15) >> 2, pp = lane & 3;
  const char* a = base + (r0 + 4 * (gi >> 1) + q) * stride + (c0 + 16 * (gi & 1) + 4 * pp) * 2;
  s16x4 lo = __builtin_amdgcn_ds_read_tr16_b64_v4i16((LAS s16x4*)(a));
  s16x4 hi = __builtin_amdgcn_ds_read_tr16_b64_v4i16((LAS s16x4*)(a + 8 * stride));
  bf16x8 r; r[0] = lo[0]; r[1] = lo[1]; r[2] = lo[2]; r[3] = lo[3]; r[4] = hi[0]; r[5] = hi[1]; r[6] = hi[2]; r[7] = hi[3];
  return r;
}
DEV bf16x8 pack8(float a0, float a1, float a2, float a3, float a4, float a5, float a6, float a7) {
  union { u32x4 u; bf16x8 b; } x; x.u[0] = pk2(a0, a1); x.u[1] = pk2(a2, a3); x.u[2] = pk2(a4, a5); x.u[3] = pk2(a6, a7); return x.b;
}
DEV int ltid_(int swave) { int z = 0; asm volatile("" : "+v"(z)); return (swave << 6) | (int)__builtin_amdgcn_mbcnt_hi(~0u, __builtin_amdgcn_mbcnt_lo(~0u, (unsigned)z)); }
#define ltid() ltid_(swave)
DEV float shx(float v, int o, int lane) { return __builtin_bit_cast(float, __builtin_amdgcn_ds_bpermute((lane ^ o) << 2, __builtin_bit_cast(int, v))); }
DEV float rscale_of(const float* ssq, int m) {
  const f32x4 a = *(const f32x4*)(ssq + (size_t)m * NPART), b = *(const f32x4*)(ssq + (size_t)m * NPART + 4);
  const float s = (a[0] + a[1]) + (a[2] + a[3]) + (b[0] + b[1]) + (b[2] + b[3]);
  return rsqrtf(s * (1.f / DM) + EPS);
}

DEV void wt_tile(const float* src, int ldsrc, bf16_t* dst, int lddst, int k0, int n0, const float* g, bool inmap, char* lds, const int swave) {
  float (*T)[65] = (float (*)[65])lds;
  const int tid = ltid();
  {
    const int kr = tid >> 4, nq = tid & 15;
    const int nn = n0 + nq * 4;
    int sn = nn;
    if (inmap) { sn = nn < 1536 ? nn : (nn < 3072 ? nn + 4 : (nn < 3076 ? nn - 3072 + 1536 : -1)); }
    f32x4 v[4];
#pragma unroll
    for (int i = 0; i < 4; ++i) {
      const int k = kr + 16 * i;
      if (sn >= 0) v[i] = *(const f32x4*)(src + (size_t)(k0 + k) * ldsrc + sn); else { v[i][0] = 0.f; v[i][1] = 0.f; v[i][2] = 0.f; v[i][3] = 0.f; }
    }
#pragma unroll
    for (int i = 0; i < 4; ++i) {
      const int k = kr + 16 * i;
      const float gg = g ? g[k0 + k] : 1.f;
      T[k][nq * 4 + 0] = v[i][0] * gg; T[k][nq * 4 + 1] = v[i][1] * gg; T[k][nq * 4 + 2] = v[i][2] * gg; T[k][nq * 4 + 3] = v[i][3] * gg;
    }
  }
  __syncthreads();
  {
    const int n = tid & 63, kq = tid >> 6;
#pragma unroll
    for (int i = 0; i < 2; ++i) {
      const int kk = (kq + 4 * i) * 8;
      u32x4 o;
      o[0] = pk2(T[kk][n], T[kk + 1][n]); o[1] = pk2(T[kk + 2][n], T[kk + 3][n]); o[2] = pk2(T[kk + 4][n], T[kk + 5][n]); o[3] = pk2(T[kk + 6][n], T[kk + 7][n]);
      *(u32x4*)(dst + (size_t)(n0 + n) * lddst + k0 + kk) = o;
    }
  }
  __syncthreads();
}

DEV void prologue_phase(CParams& p, char* lds, int vb, int nb, const int swave) {
  char* ws = p.ws;

  constexpr int T_IN = 16 * (NIN / 64), T_OUT = 16 * 16, T_UP = 16 * 64, T_DN = 64 * 16, T_G = 8;
  constexpr int T_L = T_IN + T_OUT + T_UP + T_DN + T_G;
  for (int u = vb; u < DEPTH * T_L; u += nb) {
    const int l = u / T_L; int r = u % T_L;
    if (r < T_IN) { const int kt = r % 16, nt = r / 16;
      wt_tile(p.in[9] + (size_t)l * DM * 3076, 3076, (bf16_t*)(ws + W_WTIN) + (size_t)l * NIN * DM, DM, kt * 64, nt * 64, p.in[8] + l * DM, true, lds, swave);
    } else if ((r -= T_IN) < T_OUT) { const int kt = r % 16, nt = r / 16;
      wt_tile(p.in[25] + (size_t)l * DM * DM, DM, (bf16_t*)(ws + W_WTOUT) + (size_t)l * DM * DM, DM, kt * 64, nt * 64, nullptr, false, lds, swave);
    } else if ((r -= T_OUT) < T_UP) { const int kt = r % 16, nt = r / 16;
      wt_tile(p.in[27] + (size_t)l * DM * DFF, DFF, (bf16_t*)(ws + W_WTUP) + (size_t)l * DFF * DM, DM, kt * 64, nt * 64, p.in[26] + l * DM, false, lds, swave);
    } else if ((r -= T_UP) < T_DN) { const int kt = r % 64, nt = r / 64;
      wt_tile(p.in[28] + (size_t)l * DFF * DM, DM, (bf16_t*)(ws + W_WTDN) + (size_t)l * DM * DFF, DFF, kt * 64, nt * 64, nullptr, false, lds, swave);
    } else { r -= T_DN; const int h = r & 3, which = r >> 2;
      wt_tile(p.in[which ? 14 : 12] + (size_t)(l * 4 + h) * 4096, 64, (bf16_t*)(ws + (which ? W_WXT : W_WAT)) + (size_t)(l * 4 + h) * 4096, 64, 0, 0, nullptr, false, lds, swave);
    }
  }
  const int lane = ltid() & 63, w = ltid() >> 6;
  float* xo = p.out; bf16_t* xbf = (bf16_t*)(ws + W_XBF); float* ssq = (float*)(ws + W_SSQ);
  for (int m = vb * 4 + w; m < MTOK; m += nb * 4) {
    const float* src = m < TP ? p.in[0] + (size_t)m * DM : p.in[1] + (size_t)(m - TP) * DM;
    float s = 0.f;
#pragma unroll
    for (int i = 0; i < 4; ++i) {
      const int c = i * 256 + lane * 4;
      const f32x4 v = *(const f32x4*)(src + c);
      *(f32x4*)(xo + (size_t)m * DM + c) = v;
      u32x2 pk; pk[0] = pk2(v[0], v[1]); pk[1] = pk2(v[2], v[3]);
      *(u32x2*)(xbf + (size_t)m * DM + c) = pk;
      s += v[0] * v[0] + v[1] * v[1] + v[2] * v[2] + v[3] * v[3];
    }
#pragma unroll
    for (int o = 32; o >= 1; o >>= 1) s += shx(s, o, lane);
    if (lane < NPART) ssq[(size_t)m * NPART + lane] = lane == 0 ? s : 0.f;
  }
}

constexpr int GS_B = 144;
constexpr int G_TILE = 256 * GS_B;
enum { EPI_IN = 0, EPI_RES = 1, EPI_UP = 2 };

template <int EPI>
DEV void gemm_tile(CParams& p, int layer, const bf16_t* __restrict__ A, int lda, const bf16_t* __restrict__ Bt, int K, int m0, int n0, int nt, char* lds, const int swave) {
  const int tid = ltid(), lane = tid & 63, w = __builtin_amdgcn_readfirstlane(tid >> 6), wm = w >> 1, wn = w & 1, lr = lane & 31, hh = lane >> 5;
  const int lrow = tid >> 3, lch = tid & 7;
  f32x16 acc[4][4];
#pragma unroll
  for (int j = 0; j < 4; ++j)
#pragma unroll
    for (int i = 0; i < 4; ++i) acc[j][i] = zero16();
  u32x4 ra0[8], rb0[8], ra1[8], rb1[8];
  const int nk = K / 64;
  const char* abase = (const char*)(A + (size_t)m0 * lda);
  const char* bbase = (const char*)(Bt + (size_t)n0 * K);
  const unsigned aoff = (unsigned)(lrow * lda + lch * 8) * 2u;
  const unsigned boff = (unsigned)(lrow * K + lch * 8) * 2u;
  const bool tail = m0 + 256 > MTOK;
#define GLOAD(RA, RB, kt) { _Pragma("unroll") for (int i = 0; i < 8; ++i) { const int ia = (tail && i >= 4) ? i - 4 : i; \
    RA[i] = *(const u32x4*)(abase + ((size_t)(32 * ia) * lda + (kt) * 64) * 2 + aoff); RB[i] = *(const u32x4*)(bbase + ((size_t)(32 * i) * K + (kt) * 64) * 2 + boff); } }
#define LWRITE(RA, RB, buf) { char* as_ = lds + (buf) * 2 * G_TILE; char* bs_ = as_ + G_TILE; _Pragma("unroll") for (int i = 0; i < 8; ++i) { *(u32x4*)(as_ + (lrow + 32 * i) * GS_B + lch * 16) = RA[i]; *(u32x4*)(bs_ + (lrow + 32 * i) * GS_B + lch * 16) = RB[i]; } }
  const char* asr = lds + (wm * 128 + lr) * GS_B + hh * 16;
  const char* bsr = lds + G_TILE + (wn * 128 + lr) * GS_B + hh * 16;
  char* wsw = lds + lrow * GS_B + lch * 16;
#define WR2(RA, RB, wbuf, i0) { _Pragma("unroll") for (int i = (i0); i < (i0) + 2; ++i) { \
    *(u32x4*)(wsw + (wbuf) * 2 * G_TILE + (32 * i) * GS_B) = RA[i]; *(u32x4*)(wsw + (wbuf) * 2 * G_TILE + G_TILE + (32 * i) * GS_B) = RB[i]; } }
#define COMPUTE(rbuf, RA, RB, wbuf, dowrite) { \
    _Pragma("unroll 2") for (int ks = 0; ks < 4; ++ks) { \
      bf16x8 af[4], bf[4]; \
      _Pragma("unroll") for (int i = 0; i < 4; ++i) { af[i] = lds_read8(asr + (rbuf) * 2 * G_TILE + i * 32 * GS_B + ks * 32); bf[i] = lds_read8(bsr + (rbuf) * 2 * G_TILE + i * 32 * GS_B + ks * 32); } \
      _Pragma("unroll") for (int j = 0; j < 4; ++j) _Pragma("unroll") for (int i = 0; i < 4; ++i) acc[j][i] = mfma32(bf[j], af[i], acc[j][i]); \
      if (dowrite) { if (ks == 0) WR2(RA, RB, wbuf, 0) else if (ks == 1) WR2(RA, RB, wbuf, 2) else if (ks == 2) WR2(RA, RB, wbuf, 4) else WR2(RA, RB, wbuf, 6) } \
    } }
  GLOAD(ra0, rb0, 0); GLOAD(ra1, rb1, 1); LWRITE(ra0, rb0, 0); __syncthreads();
#pragma unroll 1
  for (int kt = 0; kt < nk; kt += 2) {
    if (kt + 2 < nk) GLOAD(ra0, rb0, kt + 2);
    COMPUTE(0, ra1, rb1, 1, true);
    __syncthreads();
    const bool more = kt + 2 < nk;
    if (kt + 3 < nk) GLOAD(ra1, rb1, kt + 3);
    COMPUTE(1, ra0, rb0, 0, more);
    __syncthreads();
  }
#undef COMPUTE
#undef WR2
#undef GLOAD
#undef LWRITE
  char* ws = p.ws;
  const float* ssq = (const float*)(ws + W_SSQ);
  if (!(tail && wm == 1)) {
#pragma unroll
  for (int i = 0; i < 4; ++i) {
    const int mc = m0 + wm * 128 + i * 32 + lr;
    if (EPI == EPI_IN) {
      const float rs = rscale_of(ssq, mc);
      if (nt < 12) {
        bf16_t* prow = (bf16_t*)(ws + W_PROJ) + (size_t)mc * PW;
        float* fo = nullptr;
        if (nt >= 8) {
          const int cc = nt >= 10 ? 1 : 0;
          if (mc < TP) fo = p.out + (cc ? O_VP : O_KP) + ((size_t)layer * TP + mc) * 512 - (cc ? C_V : C_K);
          else fo = p.out + (cc ? O_VS : O_KS) + ((size_t)layer * TS + (mc - TP)) * 512 - (cc ? C_V : C_K);
        }
#pragma unroll
        for (int j = 0; j < 4; ++j)
#pragma unroll
          for (int g = 0; g < 4; ++g) {
            const int n = n0 + wn * 128 + j * 32 + 8 * g + 4 * hh;
            f32x4 v; v[0] = acc[j][i][4 * g] * rs; v[1] = acc[j][i][4 * g + 1] * rs; v[2] = acc[j][i][4 * g + 2] * rs; v[3] = acc[j][i][4 * g + 3] * rs;
            u32x2 pk; pk[0] = pk2(v[0], v[1]); pk[1] = pk2(v[2], v[3]);
            *(u32x2*)(prow + n) = pk;
            if (nt >= 8) *(f32x4*)(fo + n) = v;
          }
      } else {
        if (wn == 0 && hh == 0) {
          f32x4 v; v[0] = acc[0][i][0] * rs; v[1] = acc[0][i][1] * rs; v[2] = acc[0][i][2] * rs; v[3] = acc[0][i][3] * rs;
          *(f32x4*)((float*)(ws + W_DTRAW) + (size_t)mc * 4) = v;
        }
      }
    } else if (EPI == EPI_RES) {
      float* __restrict__ xrow = p.out + (size_t)mc * DM + n0 + wn * 128 + 4 * hh;
      bf16_t* __restrict__ brow = (bf16_t*)(ws + W_XBF) + (size_t)mc * DM + n0 + wn * 128 + 4 * hh;
      f32x4 xv[16];
#pragma unroll
      for (int q = 0; q < 16; ++q) xv[q] = *(const f32x4*)(xrow + (q >> 2) * 32 + (q & 3) * 8);
      float s = 0.f;
#pragma unroll
      for (int j = 0; j < 4; ++j)
#pragma unroll
        for (int g = 0; g < 4; ++g) {
          f32x4 v = xv[j * 4 + g];
          v[0] += acc[j][i][4 * g]; v[1] += acc[j][i][4 * g + 1]; v[2] += acc[j][i][4 * g + 2]; v[3] += acc[j][i][4 * g + 3];
          s += v[0] * v[0] + v[1] * v[1] + v[2] * v[2] + v[3] * v[3];
          *(f32x4*)(xrow + j * 32 + g * 8) = v;
          u32x2 pk; pk[0] = pk2(v[0], v[1]); pk[1] = pk2(v[2], v[3]);
          *(u32x2*)(brow + j * 32 + g * 8) = pk;
        }
      s += shx(s, 32, lane);
      if (hh == 0) ((float*)(ws + W_SSQ))[(size_t)mc * NPART + nt * 2 + wn] = s;
    } else {
      const float rs = rscale_of(ssq, mc);
      bf16_t* urow = (bf16_t*)(ws + W_U) + (size_t)mc * DFF;
#pragma unroll
      for (int j = 0; j < 4; ++j)
#pragma unroll
        for (int g = 0; g < 4; ++g) {
          const int n = n0 + wn * 128 + j * 32 + 8 * g + 4 * hh;
          float v0 = fmaxf(acc[j][i][4 * g] * rs, 0.f), v1 = fmaxf(acc[j][i][4 * g + 1] * rs, 0.f), v2 = fmaxf(acc[j][i][4 * g + 2] * rs, 0.f), v3 = fmaxf(acc[j][i][4 * g + 3] * rs, 0.f);
          u32x2 pk; pk[0] = pk2(v0 * v0, v1 * v1); pk[1] = pk2(v2 * v2, v3 * v3);
          *(u32x2*)(urow + n) = pk;
        }
    }
  }
  }
}

constexpr int GM_T = 128 * GS_B;
template <int EPI>
DEV void gemm_mini(CParams& p, int layer, const bf16_t* __restrict__ A, int lda, const bf16_t* __restrict__ Bt, int K, int n0, char* lds, const int swave) {
  const int tid = ltid(), lane = tid & 63, w = swave, lr = lane & 31, hh = lane >> 5;
  const int lrow = tid >> 3, lch = tid & 7;
  f32x16 acc[4];
#pragma unroll
  for (int j = 0; j < 4; ++j) acc[j] = zero16();
  u32x4 ra[4][4], rb[4][4];
  const int nk = K / 64;
  const char* abase = (const char*)(A + (size_t)TP * lda);
  const char* bbase = (const char*)(Bt + (size_t)n0 * K);
  const unsigned aoff = (unsigned)(lrow * lda + lch * 8) * 2u, boff = (unsigned)(lrow * K + lch * 8) * 2u;
#define MLOAD(S, kt) { _Pragma("unroll") for (int i = 0; i < 4; ++i) { ra[S][i] = *(const u32x4*)(abase + ((size_t)(32 * i) * lda + (kt) * 64) * 2 + aoff); rb[S][i] = *(const u32x4*)(bbase + ((size_t)(32 * i) * K + (kt) * 64) * 2 + boff); } }
#define MWRITE(S, buf) { char* as_ = lds + (buf) * 2 * GM_T; char* bs_ = as_ + GM_T; _Pragma("unroll") for (int i = 0; i < 4; ++i) { *(u32x4*)(as_ + (lrow + 32 * i) * GS_B + lch * 16) = ra[S][i]; *(u32x4*)(bs_ + (lrow + 32 * i) * GS_B + lch * 16) = rb[S][i]; } }
#define MSTEP(S, kk) { \
    if ((kk) + 4 < nk) MLOAD(S, (kk) + 4) \
    const char* as = lds + ((kk) & 1) * 2 * GM_T + (w * 32 + lr) * GS_B + hh * 16; \
    const char* bs = lds + ((kk) & 1) * 2 * GM_T + GM_T + lr * GS_B + hh * 16; \
    _Pragma("unroll") for (int ks = 0; ks < 4; ++ks) { \
      const bf16x8 af = lds_read8(as + ks * 32); \
      _Pragma("unroll") for (int j = 0; j < 4; ++j) { const bf16x8 bf = lds_read8(bs + j * 32 * GS_B + ks * 32); acc[j] = mfma32(bf, af, acc[j]); } \
    } \
    if ((kk) + 1 < nk) MWRITE(((S) + 1) & 3, ((kk) + 1) & 1) \
    __syncthreads(); }
  MLOAD(0, 0) MLOAD(1, 1) MLOAD(2, 2) MLOAD(3, 3) MWRITE(0, 0) __syncthreads();
#pragma unroll 1
  for (int kt = 0; kt < nk; kt += 4) { MSTEP(0, kt) MSTEP(1, kt + 1) MSTEP(2, kt + 2) MSTEP(3, kt + 3) }
#undef MSTEP
#undef MWRITE
#undef MLOAD
  char* ws = p.ws;
  const float* ssq = (const float*)(ws + W_SSQ);
  const int mc = TP + w * 32 + lr;
  if (EPI == EPI_IN) {
    const float rs = rscale_of(ssq, mc);
    if (n0 < PW) {
      bf16_t* prow = (bf16_t*)(ws + W_PROJ) + (size_t)mc * PW;
      float* fo = nullptr;
      if (n0 >= C_K) { const int cc = n0 >= C_V ? 1 : 0; fo = p.out + (cc ? O_VS : O_KS) + ((size_t)layer * TS + (mc - TP)) * 512 - (cc ? C_V : C_K); }
#pragma unroll
      for (int j = 0; j < 4; ++j)
#pragma unroll
        for (int g = 0; g < 4; ++g) {
          const int n = n0 + j * 32 + 8 * g + 4 * hh;
          f32x4 v; v[0] = acc[j][4 * g] * rs; v[1] = acc[j][4 * g + 1] * rs; v[2] = acc[j][4 * g + 2] * rs; v[3] = acc[j][4 * g + 3] * rs;
          u32x2 pk; pk[0] = pk2(v[0], v[1]); pk[1] = pk2(v[2], v[3]);
          *(u32x2*)(prow + n) = pk;
          if (n0 >= C_K) *(f32x4*)(fo + n) = v;
        }
    } else if (n0 == PW) {
      if (hh == 0) { f32x4 v; v[0] = acc[0][0] * rs; v[1] = acc[0][1] * rs; v[2] = acc[0][2] * rs; v[3] = acc[0][3] * rs; *(f32x4*)((float*)(ws + W_DTRAW) + (size_t)mc * 4) = v; }
    }
  } else if (EPI == EPI_RES) {
    float* __restrict__ xrow = p.out + (size_t)mc * DM + n0 + 4 * hh;
    bf16_t* __restrict__ brow = (bf16_t*)(ws + W_XBF) + (size_t)mc * DM + n0 + 4 * hh;
    f32x4 xv[16];
#pragma unroll
    for (int q = 0; q < 16; ++q) xv[q] = *(const f32x4*)(xrow + (q >> 2) * 32 + (q & 3) * 8);
    float s = 0.f;
#pragma unroll
    for (int j = 0; j < 4; ++j)
#pragma unroll
      for (int g = 0; g < 4; ++g) {
        f32x4 v = xv[j * 4 + g];
        v[0] += acc[j][4 * g]; v[1] += acc[j][4 * g + 1]; v[2] += acc[j][4 * g + 2]; v[3] += acc[j][4 * g + 3];
        s += v[0] * v[0] + v[1] * v[1] + v[2] * v[2] + v[3] * v[3];
        *(f32x4*)(xrow + j * 32 + g * 8) = v;
        u32x2 pk; pk[0] = pk2(v[0], v[1]); pk[1] = pk2(v[2], v[3]);
        *(u32x2*)(brow + j * 32 + g * 8) = pk;
      }
    s += shx(s, 32, lane);
    if (hh == 0) ((float*)(ws + W_SSQ))[(size_t)mc * NPART + (n0 >> 7)] = s;
  } else {
    const float rs = rscale_of(ssq, mc);
    bf16_t* urow = (bf16_t*)(ws + W_U) + (size_t)mc * DFF;
#pragma unroll
    for (int j = 0; j < 4; ++j)
#pragma unroll
      for (int g = 0; g < 4; ++g) {
        const int n = n0 + j * 32 + 8 * g + 4 * hh;
        float v0 = fmaxf(acc[j][4 * g] * rs, 0.f), v1 = fmaxf(acc[j][4 * g + 1] * rs, 0.f), v2 = fmaxf(acc[j][4 * g + 2] * rs, 0.f), v3 = fmaxf(acc[j][4 * g + 3] * rs, 0.f);
        u32x2 pk; pk[0] = pk2(v0 * v0, v1 * v1); pk[1] = pk2(v2 * v2, v3 * v3);
        *(u32x2*)(urow + n) = pk;
      }
  }
}

template <int EPI>
DEV void gemm_phase(CParams& p, int layer, const bf16_t* A, int lda, const bf16_t* Bt, int K, int NT, char* lds, int vb, int nb, const int swave) {
  constexpr int MT = TP / 256;
  const int ntiles = MT * NT;
  for (int t = vb; t < ntiles; t += nb) {
    const int mt = t / NT, nt = t % NT;
    gemm_tile<EPI>(p, layer, A, lda, Bt, K, mt * 256, nt * 256, nt, lds, swave);
  }
  const int nmini = EPI == EPI_IN ? (PW + 128) / 128 : NT * 2;
  for (int t = nb - 1 - vb; t < nmini; t += nb) gemm_mini<EPI>(p, layer, A, lda, Bt, K, t * 128, lds, swave);
}

DEV void cache_conv_unit(CParams& p, int layer, int u, const int swave) {
  const int which = u >> 8, uu = u & 255;
  const float* src = p.in[which ? 3 : 2] + (size_t)layer * 8 * 2048 * 512 + (size_t)uu * 32768;
  bf16_t* dst = (bf16_t*)(p.ws + (which ? W_VC : W_KC)) + (size_t)uu * 32768;
#pragma unroll 4
  for (int i = 0; i < 16; ++i) {
    const int e = (i * 256 + ltid()) * 8;
    const f32x4 a = *(const f32x4*)(src + e), b = *(const f32x4*)(src + e + 4);
    u32x4 o; o[0] = pk2(a[0], a[1]); o[1] = pk2(a[2], a[3]); o[2] = pk2(b[0], b[1]); o[3] = pk2(b[2], b[3]);
    *(u32x4*)(dst + e) = o;
  }
}

constexpr int CS_B = 576;
constexpr int SLOT = 64 * CS_B;
constexpr int XR_B = 528;

template <int MODE>
DEV void chunk_unit(CParams& p, int layer, int b, int c, char* lds, const int swave) {
  constexpr int mode = MODE;
  const int tid = ltid(), lane = tid & 63, w = tid >> 6, lr = lane & 31, hh = lane >> 5;
  char* ws = p.ws;
  const int L = mode == 2 ? 16 : 64;
  const int row0 = mode == 2 ? TP + b * 16 : b * 16384 + c * 64;
  const bf16_t* proj = (const bf16_t*)(ws + W_PROJ);
  bf16_t* mixed = (bf16_t*)(ws + W_MIX);
  float* smallf = (float*)(lds + 4 * SLOT);
  float* dtL = smallf, *csL = smallf + 256, *red = smallf + 512, *chc = smallf + 768;

  auto ld_pair = [&](int t, int col, const float* st, int stw) -> uint32_t {
    if (t >= L) return 0u;
    if (t >= 0) return *(const uint32_t*)(proj + (size_t)(row0 + t) * PW + col);
    if (mode == 2) { const float* s = st + (size_t)(3 + t) * stw; return pk2(s[0], s[1]); }
    if (c > 0) return *(const uint32_t*)(proj + (size_t)(row0 + t) * PW + col);
    return 0u;
  };

  {
    const float bias = p.in[19][layer * 4 + w], aneg = -fexp(p.in[20][layer * 4 + w]);
    const int tc = lane < L ? lane : L - 1;
    const float raw = ((const float*)(ws + W_DTRAW))[(size_t)(row0 + tc) * 4 + w];
    const float dtv = lane < L ? softplusf_(raw + bias) : 0.f;
    float cs = dtv * aneg;
#pragma unroll
    for (int o = 1; o < 64; o <<= 1) {
      const float y = __builtin_bit_cast(float, __builtin_amdgcn_ds_bpermute(((lane - o) & 63) << 2, __builtin_bit_cast(int, cs)));
      if (lane >= o) cs += y;
    }
    dtL[lane * 4 + w] = dtv; csL[lane * 4 + w] = cs;
    const int ch = tid;
    chc[ch] = p.in[13][layer * 256 + ch]; chc[256 + ch] = p.in[15][layer * 256 + ch]; chc[512 + ch] = -8.f * softplusf_(-p.in[16][layer * 256 + ch]);
  }
  if (mode == 1) {
    if (c == 255) {
      float* o = p.out + O_LCP + (size_t)(layer * 2 + b) * 768;
      for (int idx = tid; idx < 768; idx += 256) { const int j = idx >> 8, cc = idx & 255; o[idx] = bf2f(proj[(size_t)(row0 + L - 3 + j) * PW + C_XR + cc]); }
    }
    const bf16_t* hl = (const bf16_t*)(ws + W_LHL);
    const bf16_t* ca = (const bf16_t*)(ws + W_LCA);
    const float* hin = (const float*)(ws + W_LRUB) + (size_t)(b * 256 + c) * 256;
#pragma unroll 2
    for (int q = 0; q < 8; ++q) {
      const int it = tid + 256 * q, t2 = it >> 5, cg8 = (it & 31) * 8;
      const u32x4 gv = *(const u32x4*)(proj + (size_t)(row0 + t2) * PW + C_GATE + cg8);
      const u32x4 hv = *(const u32x4*)(hl + (size_t)(row0 + t2) * 256 + cg8);
      const u32x4 cv = *(const u32x4*)(ca + (size_t)(row0 + t2) * 256 + cg8);
      const f32x4 i0 = *(const f32x4*)(hin + cg8), i1 = *(const f32x4*)(hin + cg8 + 4);
      u32x4 o;
      o[0] = pk2(geluf_(bflo(gv[0])) * (bflo(hv[0]) + bflo(cv[0]) * i0[0]), geluf_(bfhi(gv[0])) * (bfhi(hv[0]) + bfhi(cv[0]) * i0[1]));
      o[1] = pk2(geluf_(bflo(gv[1])) * (bflo(hv[1]) + bflo(cv[1]) * i0[2]), geluf_(bfhi(gv[1])) * (bfhi(hv[1]) + bfhi(cv[1]) * i0[3]));
      o[2] = pk2(geluf_(bflo(gv[2])) * (bflo(hv[2]) + bflo(cv[2]) * i1[0]), geluf_(bfhi(gv[2])) * (bfhi(hv[2]) + bfhi(cv[2]) * i1[1]));
      o[3] = pk2(geluf_(bflo(gv[3])) * (bflo(hv[3]) + bflo(cv[3]) * i1[2]), geluf_(bfhi(gv[3])) * (bfhi(hv[3]) + bfhi(cv[3]) * i1[3]));
      *(u32x4*)(mixed + (size_t)(row0 + t2) * DM + cg8) = o;
    }
    __syncthreads();
  } else {
  {
    const int cp = tid & 127, th = tid >> 7, ch = cp * 2;
    const float* cw = p.in[10] + (size_t)layer * 4 * 256;
    const float w00 = cw[ch], w01 = cw[ch + 1], w10 = cw[256 + ch], w11 = cw[256 + ch + 1], w20 = cw[512 + ch], w21 = cw[512 + ch + 1], w30 = cw[768 + ch], w31 = cw[768 + ch + 1];
    const float b0 = p.in[11][layer * 256 + ch], b1 = p.in[11][layer * 256 + ch + 1];
    const float* st = p.in[4] + ((size_t)(layer * 8 + b) * 3) * 256 + ch;
    float x0a = 0, x0b = 0, x1a = 0, x1b = 0, x2a = 0, x2b = 0;
    {
      uint32_t u;
      u = ld_pair(th * 32 - 3, C_XR + ch, st, 256); x0a = bflo(u); x0b = bfhi(u);
      u = ld_pair(th * 32 - 2, C_XR + ch, st, 256); x1a = bflo(u); x1b = bfhi(u);
      u = ld_pair(th * 32 - 1, C_XR + ch, st, 256); x2a = bflo(u); x2b = bfhi(u);
    }
#pragma unroll 8
    for (int tt = 0; tt < 32; ++tt) {
      const int t = th * 32 + tt;
      const uint32_t u = ld_pair(t, C_XR + ch, st, 256);
      const float xa = bflo(u), xb = bfhi(u);
      float oa = b0 + w00 * x0a + w10 * x1a + w20 * x2a + w30 * xa;
      float ob = b1 + w01 * x0b + w11 * x1b + w21 * x2b + w31 * xb;
      if (t >= L) { oa = 0.f; ob = 0.f; }
      *(uint32_t*)(lds + t * XR_B + ch * 2) = pk2(oa, ob);
      x0a = x1a; x0b = x1b; x1a = x2a; x1b = x2b; x2a = xa; x2b = xb;
    }
    if (mode == 2 || (mode == 1 && c == 255)) {
      float* o = p.out + (mode == 2 ? O_LCS + (size_t)(layer * 8 + b) * 768 : O_LCP + (size_t)(layer * 2 + b) * 768);
      for (int idx = tid; idx < 768; idx += 256) { const int j = idx >> 8, cc = idx & 255; o[idx] = bf2f(proj[(size_t)(row0 + L - 3 + j) * PW + C_XR + cc]); }
    }
  }
  __syncthreads();
  {
    float2* AB = (float2*)(lds + SLOT);
    float* Hs = (float*)(lds + 3 * SLOT);
    const bf16_t* wat = (const bf16_t*)(ws + W_WAT) + (size_t)layer * 4 * 4096;
    const bf16_t* wxt = (const bf16_t*)(ws + W_WXT) + (size_t)layer * 4 * 4096;
    for (int pass = 0; pass < 2; ++pass) {
      const int hb = pass * 2 + (w >> 1), ti = w & 1;
      f32x16 ar[2], ai[2];
      ar[0] = zero16(); ar[1] = zero16(); ai[0] = zero16(); ai[1] = zero16();
#pragma unroll
      for (int ks = 0; ks < 4; ++ks) {
        const bf16x8 xf = lds_read8(lds + (ti * 32 + lr) * XR_B + (hb * 64 + ks * 16 + hh * 8) * 2);
#pragma unroll
        for (int jt = 0; jt < 2; ++jt) {
          const size_t wo = (size_t)hb * 4096 + (size_t)(jt * 32 + lr) * 64 + ks * 16 + hh * 8;
          const bf16x8 fa = *(const bf16x8*)(wat + wo), fx = *(const bf16x8*)(wxt + wo);
          ar[jt] = mfma32(fa, xf, ar[jt]); ai[jt] = mfma32(fx, xf, ai[jt]);
        }
      }
      const int t = ti * 32 + lr;
#pragma unroll
      for (int jt = 0; jt < 2; ++jt)
#pragma unroll
        for (int r = 0; r < 16; ++r) {
          const int j = jt * 32 + 8 * (r >> 2) + 4 * hh + (r & 3);
          const int ch = hb * 64 + j;
          const float rg = sigmoidf_(ar[jt][r] + chc[ch]);
          const float ig = sigmoidf_(ai[jt][r] + chc[256 + ch]);
          const float la = rg * chc[512 + ch];
          const float a = fexp(la);
          const float xv = bf2f(*(const bf16_t*)(lds + t * XR_B + ch * 2));
          const float bb = __builtin_amdgcn_sqrtf(fmaxf(neg_expm1(2.f * la), 0.f)) * (ig * xv);
          AB[t * 129 + (w >> 1) * 64 + j] = make_float2(a, bb);
        }
      __syncthreads();
      if (tid < 128) {
        const int ch = pass * 128 + tid;
        float h = 0.f, ap = 1.f;
        if (mode == 1) h = ((const float*)(ws + W_LRUB))[(size_t)(b * 256 + c) * 256 + ch];
        else if (mode == 2) h = p.in[5][(size_t)(layer * 8 + b) * 256 + ch];
        for (int t2 = 0; t2 < L; ++t2) {
          const float2 v = AB[t2 * 129 + tid];
          h = v.x * h + v.y; ap *= v.x;
          Hs[t2 * 128 + tid] = h;
          if (mode == 0) { ((bf16_t*)(ws + W_LHL))[(size_t)(row0 + t2) * 256 + ch] = f2bf(h); ((bf16_t*)(ws + W_LCA))[(size_t)(row0 + t2) * 256 + ch] = f2bf(ap); }
        }
        if (mode == 0) { ((float*)(ws + W_LRUA))[(size_t)(b * 256 + c) * 256 + ch] = ap; ((float*)(ws + W_LRUB))[(size_t)(b * 256 + c) * 256 + ch] = h; }
        if (mode == 2) p.out[O_LHS + (size_t)(layer * 8 + b) * 256 + ch] = h;
      }
      __syncthreads();
      if (mode != 0) {
        for (int it = tid; it < L * 16; it += 256) {
          const int t2 = it >> 4, cg8 = (it & 15) * 8;
          const u32x4 gv = *(const u32x4*)(proj + (size_t)(row0 + t2) * PW + C_GATE + pass * 128 + cg8);
          const f32x4 h0 = *(const f32x4*)(Hs + t2 * 128 + cg8), h1 = *(const f32x4*)(Hs + t2 * 128 + cg8 + 4);
          u32x4 o;
          o[0] = pk2(geluf_(bflo(gv[0])) * h0[0], geluf_(bfhi(gv[0])) * h0[1]);
          o[1] = pk2(geluf_(bflo(gv[1])) * h0[2], geluf_(bfhi(gv[1])) * h0[3]);
          o[2] = pk2(geluf_(bflo(gv[2])) * h1[0], geluf_(bfhi(gv[2])) * h1[1]);
          o[3] = pk2(geluf_(bflo(gv[3])) * h1[2], geluf_(bfhi(gv[3])) * h1[3]);
          *(u32x4*)(mixed + (size_t)(row0 + t2) * DM + pass * 128 + cg8) = o;
        }
        __syncthreads();
      }
    }
  }
  }
  {
    const int npairs = mode == 0 ? 256 : 384;
    const float* cw = p.in[17] + (size_t)layer * 4 * 768;
    const float* cb = p.in[18] + (size_t)layer * 768;
    for (int item = tid; item < npairs * 4; item += 256) {
      const int pr = item % npairs, tq = item / npairs, ch = pr * 2;
      const float w00 = cw[ch], w01 = cw[ch + 1], w10 = cw[768 + ch], w11 = cw[768 + ch + 1], w20 = cw[1536 + ch], w21 = cw[1536 + ch + 1], w30 = cw[2304 + ch], w31 = cw[2304 + ch + 1];
      const float b0 = cb[ch], b1 = cb[ch + 1];
      const float* st = p.in[6] + ((size_t)(layer * 8 + b) * 3) * 768 + ch;
      const int sec = ch >> 8, cl = ch & 255, hd = cl >> 6;
      float x0a, x0b, x1a, x1b, x2a, x2b;
      {
        uint32_t u;
        u = ld_pair(tq * 16 - 3, C_XBC + ch, st, 768); x0a = bflo(u); x0b = bfhi(u);
        u = ld_pair(tq * 16 - 2, C_XBC + ch, st, 768); x1a = bflo(u); x1b = bfhi(u);
        u = ld_pair(tq * 16 - 1, C_XBC + ch, st, 768); x2a = bflo(u); x2b = bfhi(u);
      }
      const float cslast = csL[63 * 4 + hd];
#pragma unroll 4
      for (int tt = 0; tt < 16; ++tt) {
        const int t = tq * 16 + tt;
        const uint32_t u = ld_pair(t, C_XBC + ch, st, 768);
        const float xa = bflo(u), xb = bfhi(u);
        float oa = siluf_(b0 + w00 * x0a + w10 * x1a + w20 * x2a + w30 * xa);
        float ob = siluf_(b1 + w01 * x0b + w11 * x1b + w21 * x2b + w31 * xb);
        if (t >= L) { oa = 0.f; ob = 0.f; }
        *(uint32_t*)(lds + sec * SLOT + t * CS_B + cl * 2) = pk2(oa, ob);
        if (sec == 0 && mode != 1) {
          const float sc = fexp(cslast - csL[t * 4 + hd]) * dtL[t * 4 + hd];
          *(uint32_t*)(lds + 3 * SLOT + t * CS_B + cl * 2) = pk2(oa * sc, ob * sc);
        }
        x0a = x1a; x0b = x1b; x1a = x2a; x1b = x2b; x2a = xa; x2b = xb;
      }
    }
    if (mode == 2 || (mode == 1 && c == 255)) {
      float* o = p.out + (mode == 2 ? O_SCS + (size_t)(layer * 8 + b) * 2304 : O_SCP + (size_t)(layer * 2 + b) * 2304);
      for (int idx = tid; idx < 2304; idx += 256) { const int j = idx / 768, cc = idx % 768; o[idx] = bf2f(proj[(size_t)(row0 + L - 3 + j) * PW + C_XBC + cc]); }
    }
  }
  __syncthreads();
  const int hd = w, grp = w >> 1;
  const char* Xs = lds, *Bm = lds + SLOT, *Cm = lds + 2 * SLOT, *Xw = lds + 3 * SLOT;
  if (mode != 1) {
    f32x16 sacc[4][2];
#pragma unroll
    for (int a = 0; a < 4; ++a) { sacc[a][0] = zero16(); sacc[a][1] = zero16(); }
#pragma unroll
    for (int ks = 0; ks < 4; ++ks) {
      bf16x8 xf[2];
      xf[0] = tr8(Xw, CS_B, ks * 16, hd * 64, lane); xf[1] = tr8(Xw, CS_B, ks * 16, hd * 64 + 32, lane);
#pragma unroll
      for (int nt = 0; nt < 4; ++nt) {
        const bf16x8 bfr = tr8(Bm, CS_B, ks * 16, grp * 128 + nt * 32, lane);
        sacc[nt][0] = mfma32(bfr, xf[0], sacc[nt][0]); sacc[nt][1] = mfma32(bfr, xf[1], sacc[nt][1]);
      }
    }
    const float dec = fexp(csL[63 * 4 + hd]);
    if (mode == 0) {
      bf16_t* S = (bf16_t*)(ws + W_SSDS) + ((size_t)(b * 256 + c) * 4 + hd) * 8192;
#pragma unroll
      for (int pt = 0; pt < 2; ++pt)
#pragma unroll
        for (int nt = 0; nt < 4; ++nt)
#pragma unroll
          for (int g = 0; g < 4; ++g) {
            u32x2 pk; pk[0] = pk2(sacc[nt][pt][4 * g], sacc[nt][pt][4 * g + 1]); pk[1] = pk2(sacc[nt][pt][4 * g + 2], sacc[nt][pt][4 * g + 3]);
            *(u32x2*)(S + (size_t)(pt * 32 + lr) * 128 + nt * 32 + 8 * g + 4 * hh) = pk;
          }
      if (lane == 0) ((float*)(ws + W_SSDDEC))[(size_t)(b * 256 + c) * 4 + hd] = dec;
    } else {
      const float* h0 = p.in[7] + ((size_t)(layer * 8 + b) * 4 + hd) * 8192;
      float* ho = p.out + O_SHS + ((size_t)(layer * 8 + b) * 4 + hd) * 8192;
#pragma unroll
      for (int pt = 0; pt < 2; ++pt)
#pragma unroll
        for (int nt = 0; nt < 4; ++nt)
#pragma unroll
          for (int g = 0; g < 4; ++g) {
            const size_t o = (size_t)(pt * 32 + lr) * 128 + nt * 32 + 8 * g + 4 * hh;
            f32x4 v = *(const f32x4*)(h0 + o);
            v[0] = dec * v[0] + sacc[nt][pt][4 * g]; v[1] = dec * v[1] + sacc[nt][pt][4 * g + 1]; v[2] = dec * v[2] + sacc[nt][pt][4 * g + 2]; v[3] = dec * v[3] + sacc[nt][pt][4 * g + 3];
            *(f32x4*)(ho + o) = v;
          }
    }
  }
  if (mode != 0) {
    f32x16 G[2][2];
    f32x16 YI[2][2];
#pragma unroll
    for (int a = 0; a < 2; ++a) { G[a][0] = zero16(); G[a][1] = zero16(); YI[a][0] = zero16(); YI[a][1] = zero16(); }
    const bf16_t* hst = (const bf16_t*)(ws + W_SSDS) + ((size_t)(b * 256 + c) * 4 + hd) * 8192;
    const float* h0 = p.in[7] + ((size_t)(layer * 8 + b) * 4 + hd) * 8192;
#pragma unroll
    for (int ks = 0; ks < 8; ++ks) {
      bf16x8 cf[2], bfr[2], hf[2];
#pragma unroll
      for (int a = 0; a < 2; ++a) {
        cf[a] = lds_read8(Cm + (a * 32 + lr) * CS_B + (grp * 128 + ks * 16 + hh * 8) * 2);
        bfr[a] = lds_read8(Bm + (a * 32 + lr) * CS_B + (grp * 128 + ks * 16 + hh * 8) * 2);
        const size_t ho = (size_t)(a * 32 + lr) * 128 + ks * 16 + hh * 8;
        if (mode == 1) hf[a] = *(const bf16x8*)(hst + ho);
        else { const f32x4 u0 = *(const f32x4*)(h0 + ho), u1 = *(const f32x4*)(h0 + ho + 4); hf[a] = pack8(u0[0], u0[1], u0[2], u0[3], u1[0], u1[1], u1[2], u1[3]); }
      }
#pragma unroll
      for (int a = 0; a < 2; ++a)
#pragma unroll
        for (int it = 0; it < 2; ++it) { G[a][it] = mfma32(bfr[a], cf[it], G[a][it]); YI[a][it] = mfma32(hf[a], cf[it], YI[a][it]); }
    }
    bf16x8 mf[2][4];
#pragma unroll
    for (int it = 0; it < 2; ++it) {
      const int i = it * 32 + lr;
      const float csi = csL[i * 4 + hd];
#pragma unroll
      for (int jt = 0; jt < 2; ++jt) {
        float v[16];
#pragma unroll
        for (int r = 0; r < 16; ++r) {
          const int j = jt * 32 + 8 * (r >> 2) + 4 * hh + (r & 3);
          const float e = j <= i ? fexp(csi - csL[j * 4 + hd]) * dtL[j * 4 + hd] : 0.f;
          v[r] = G[jt][it][r] * e;
        }
        mf[it][jt * 2 + 0] = pack8(v[0], v[1], v[2], v[3], v[4], v[5], v[6], v[7]);
        mf[it][jt * 2 + 1] = pack8(v[8], v[9], v[10], v[11], v[12], v[13], v[14], v[15]);
      }
    }
    f32x16 Y[2][2];
#pragma unroll
    for (int a = 0; a < 2; ++a) { Y[a][0] = zero16(); Y[a][1] = zero16(); }
#pragma unroll
    for (int ks = 0; ks < 4; ++ks) {
#pragma unroll
      for (int pt = 0; pt < 2; ++pt) {
        const bf16x8 xf = tr8(Xs, CS_B, ks * 16, hd * 64 + pt * 32, lane);
        Y[pt][0] = mfma32(xf, mf[0][ks], Y[pt][0]); Y[pt][1] = mfma32(xf, mf[1][ks], Y[pt][1]);
      }
    }
    const float Dh = p.in[21][layer * 4 + hd];
    float ssq2[2];
#pragma unroll
    for (int it = 0; it < 2; ++it) {
      const int i = it * 32 + lr;
      const int ic = i < L ? i : L - 1;
      const float ecs = fexp(csL[i * 4 + hd]);
      float s = 0.f;
#pragma unroll
      for (int pt = 0; pt < 2; ++pt)
#pragma unroll
        for (int g = 0; g < 4; ++g) {
          const int pp = pt * 32 + 8 * g + 4 * hh;
          const u32x2 xv = *(const u32x2*)(Xs + i * CS_B + (hd * 64 + pp) * 2);
          const u32x2 zv = *(const u32x2*)(proj + (size_t)(row0 + ic) * PW + C_Z + hd * 64 + pp);
          float y0 = Y[pt][it][4 * g] + ecs * YI[pt][it][4 * g] + Dh * bflo(xv[0]);
          float y1 = Y[pt][it][4 * g + 1] + ecs * YI[pt][it][4 * g + 1] + Dh * bfhi(xv[0]);
          float y2 = Y[pt][it][4 * g + 2] + ecs * YI[pt][it][4 * g + 2] + Dh * bflo(xv[1]);
          float y3 = Y[pt][it][4 * g + 3] + ecs * YI[pt][it][4 * g + 3] + Dh * bfhi(xv[1]);
          y0 *= siluf_(bflo(zv[0])); y1 *= siluf_(bfhi(zv[0])); y2 *= siluf_(bflo(zv[1])); y3 *= siluf_(bfhi(zv[1]));
          Y[pt][it][4 * g] = y0; Y[pt][it][4 * g + 1] = y1; Y[pt][it][4 * g + 2] = y2; Y[pt][it][4 * g + 3] = y3;
          s += y0 * y0 + y1 * y1 + y2 * y2 + y3 * y3;
        }
      s += shx(s, 32, lane);
      ssq2[it] = s;
      if (hh == 0) red[hd * 64 + i] = s;
    }
    __syncthreads();
    const float* ng = p.in[22] + layer * 256 + hd * 64;
#pragma unroll
    for (int it = 0; it < 2; ++it) {
      const int i = it * 32 + lr;
      const float tot = red[(grp * 2) * 64 + i] + red[(grp * 2 + 1) * 64 + i];
      const float rs = rsqrtf(tot * (1.f / 128.f) + EPS);
      if (i < L) {
#pragma unroll
        for (int pt = 0; pt < 2; ++pt)
#pragma unroll
          for (int g = 0; g < 4; ++g) {
            const int pp = pt * 32 + 8 * g + 4 * hh;
            const f32x4 gv = *(const f32x4*)(ng + pp);
            u32x2 pk; pk[0] = pk2(Y[pt][it][4 * g] * rs * gv[0], Y[pt][it][4 * g + 1] * rs * gv[1]); pk[1] = pk2(Y[pt][it][4 * g + 2] * rs * gv[2], Y[pt][it][4 * g + 3] * rs * gv[3]);
            *(u32x2*)(mixed + (size_t)(row0 + i) * DM + 256 + hd * 64 + pp) = pk;
          }
      }
    }
    (void)ssq2;
  }
  __syncthreads();
}

DEV void ssd_scan_unit(CParams& p, int layer, int su, const int swave) {
  const int gid = su * 256 + ltid();
  const int b = gid >> 12, rem = gid & 4095, h = rem >> 10, pn = rem & 1023;
  bf16_t* S = (bf16_t*)(p.ws + W_SSDS) + ((size_t)(b * 256) * 4 + h) * 8192 + (size_t)pn * 8;
  const float* dec = (const float*)(p.ws + W_SSDDEC) + (size_t)(b * 256) * 4 + h;
  float hs[8];
#pragma unroll
  for (int i = 0; i < 8; ++i) hs[i] = 0.f;
  for (int cb = 0; cb < 256; cb += 16) {
    u32x4 sv[16]; float dv[16];
#pragma unroll
    for (int k = 0; k < 16; ++k) { sv[k] = *(const u32x4*)(S + (size_t)(cb + k) * 4 * 8192); dv[k] = dec[(size_t)(cb + k) * 4]; }
#pragma unroll
    for (int k = 0; k < 16; ++k) {
      u32x4 o; o[0] = pk2(hs[0], hs[1]); o[1] = pk2(hs[2], hs[3]); o[2] = pk2(hs[4], hs[5]); o[3] = pk2(hs[6], hs[7]);
      *(u32x4*)(S + (size_t)(cb + k) * 4 * 8192) = o;
#pragma unroll
      for (int i = 0; i < 4; ++i) { hs[2 * i] = dv[k] * hs[2 * i] + bflo(sv[k][i]); hs[2 * i + 1] = dv[k] * hs[2 * i + 1] + bfhi(sv[k][i]); }
    }
  }
  float* o = p.out + O_SHP + ((size_t)(layer * 2 + b) * 4 + h) * 8192 + (size_t)pn * 8;
  f32x4 o0, o1; o0[0] = hs[0]; o0[1] = hs[1]; o0[2] = hs[2]; o0[3] = hs[3]; o1[0] = hs[4]; o1[1] = hs[5]; o1[2] = hs[6]; o1[3] = hs[7];
  *(f32x4*)o = o0; *(f32x4*)(o + 4) = o1;
}
DEV void lru_scan_unit(CParams& p, int layer, int b, const int swave) {
  const int ch = ltid();
  const float* A = (const float*)(p.ws + W_LRUA) + (size_t)b * 256 * 256 + ch;
  float* B = (float*)(p.ws + W_LRUB) + (size_t)b * 256 * 256 + ch;
  float h = 0.f;
  for (int cb = 0; cb < 256; cb += 16) {
    float av[16], bv[16];
#pragma unroll
    for (int k = 0; k < 16; ++k) { av[k] = A[(size_t)(cb + k) * 256]; bv[k] = B[(size_t)(cb + k) * 256]; }
#pragma unroll
    for (int k = 0; k < 16; ++k) { B[(size_t)(cb + k) * 256] = h; h = av[k] * h + bv[k]; }
  }
  p.out[O_LHP + (size_t)(layer * 2 + b) * 256 + ch] = h;
}

constexpr int AK_B = 272, AV_B = 320;
constexpr int A_KT = 64 * AK_B, A_VT = 64 * AV_B;
constexpr int A_BUF = A_KT + A_VT;

template <bool SAMPLE>
DEV void attn_unit(CParams& p, int layer, int unit, float lam, float lam_init, char* lds, const int swave) {
  const int tid = ltid(), lane = tid & 63, w = __builtin_amdgcn_readfirstlane(tid >> 6), lr = lane & 31, hh = lane >> 5;
  char* ws = p.ws;
  const bf16_t* proj = (const bf16_t*)(ws + W_PROJ);
  constexpr bool sample = SAMPLE;
  int b, head, qb = 0, ntiles;
  if (sample) { b = unit >> 2; head = unit & 3; ntiles = 33; }
  else { const int u = unit - 32; qb = 127 - (u >> 3); b = (u >> 2) & 1; head = u & 3; ntiles = 2 * qb + 2; }
  const int my_tiles = sample ? (w == 0 ? 33 : 0) : (w < 2 ? ntiles - 1 : ntiles);
  int qrow;
  if (sample) qrow = TP + b * 16 + (lr < 16 ? lr : 15);
  else qrow = b * 16384 + qb * 128 + w * 32 + lr;
  bf16x8 qf[2][4];
#pragma unroll
  for (int br = 0; br < 2; ++br)
#pragma unroll
    for (int ks = 0; ks < 4; ++ks) qf[br][ks] = *(const bf16x8*)(proj + (size_t)qrow * PW + C_Q + head * 128 + br * 64 + ks * 16 + hh * 8);
  const int krow = tid >> 4, kch = tid & 15;
  u32x4 rk[4], rv[4];
  const unsigned voffP = (unsigned)(krow * PW + kch * 8) * 2u;
  const unsigned voffC = (unsigned)(krow * 512 + kch * 8) * 2u;
  auto kbase = [&](int t, int i, unsigned& voff, size_t& vdelta) -> const char* {
    if (sample && t < 32) { voff = voffC; vdelta = W_VC - W_KC; return ws + W_KC + ((size_t)(b * 2048 + t * 64 + 16 * i) * 512 + head * 128) * 2; }
    voff = voffP; vdelta = (size_t)(C_V - C_K) * 2;
    if (sample) return (const char*)proj + ((size_t)(TP + b * 16) * PW + C_K + head * 128) * 2;
    return (const char*)proj + ((size_t)(b * 16384 + t * 64 + 16 * i) * PW + C_K + head * 128) * 2;
  };
  auto gloadK = [&](int t) {
#pragma unroll
    for (int i = 0; i < 4; ++i) { unsigned voff; size_t vd; const char* kb = kbase(t, i, voff, vd); rk[i] = *(const u32x4*)(kb + voff); }
  };
  auto gloadV = [&](int t) {
#pragma unroll
    for (int i = 0; i < 4; ++i) { unsigned voff; size_t vd; const char* kb = kbase(t, i, voff, vd); rv[i] = *(const u32x4*)(kb + vd + voff); }
  };
  auto lwrite = [&](int buf) {
    char* ks_ = lds + buf * A_BUF; char* vs_ = ks_ + A_KT;
#pragma unroll
    for (int i = 0; i < 4; ++i) {
      const int r = krow + 16 * i;
      *(u32x4*)(ks_ + r * AK_B + kch * 16) = rk[i];
      *(u32x4*)(vs_ + r * AV_B + kch * 16) = rv[i];
    }
  };
  f32x16 O1[4], O2[4];
#pragma unroll
  for (int e = 0; e < 4; ++e) { O1[e] = zero16(); O2[e] = zero16(); }
  float ls[2] = {0.f, 0.f};
  const float cexp = 0.125f * 1.4426950408889634f;
  gloadK(0); gloadV(0); lwrite(0); __syncthreads();
  float nmc[2] = {0.f, 0.f};
  if (my_tiles > 0) {
#pragma unroll
    for (int br = 0; br < 2; ++br) {
      f32x16 S0 = zero16(), S1 = zero16();
#pragma unroll
      for (int ks = 0; ks < 4; ++ks) {
        const bf16x8 k0 = lds_read8(lds + lr * AK_B + (br * 64 + ks * 16 + hh * 8) * 2);
        const bf16x8 k1 = lds_read8(lds + (32 + lr) * AK_B + (br * 64 + ks * 16 + hh * 8) * 2);
        S0 = mfma32(k0, qf[br][ks], S0); S1 = mfma32(k1, qf[br][ks], S1);
      }
      float m = S0[0];
#pragma unroll
      for (int r = 1; r < 16; ++r) m = fmaxf(m, S0[r]);
#pragma unroll
      for (int r = 0; r < 16; ++r) m = fmaxf(m, S1[r]);
      m = fmaxf(m, shx(m, 32, lane));
      nmc[br] = -m * cexp;
    }
  }
  for (int t = 0; t < ntiles; ++t) {
    const int tn = SAMPLE ? t + 1 : (t + 1 < ntiles ? t + 1 : t);
    if (!SAMPLE || t + 1 < ntiles) gloadK(tn);
    if (t < my_tiles) {
      const char* Ks = lds + (t & 1) * A_BUF; const char* Vs = Ks + A_KT;
      bf16x8 pf[2][4];
      f32x16 S0, S1;
      auto qk = [&](int br) {
        const f32x16 zc = {0.f, 0.f, 0.f, 0.f, 0.f, 0.f, 0.f, 0.f, 0.f, 0.f, 0.f, 0.f, 0.f, 0.f, 0.f, 0.f};
#pragma unroll
        for (int ks = 0; ks < 4; ++ks) {
          const bf16x8 k0 = lds_read8(Ks + lr * AK_B + (br * 64 + ks * 16 + hh * 8) * 2);
          const bf16x8 k1 = lds_read8(Ks + (32 + lr) * AK_B + (br * 64 + ks * 16 + hh * 8) * 2);
          S0 = mfma32(k0, qf[br][ks], ks == 0 ? zc : S0); S1 = mfma32(k1, qf[br][ks], ks == 0 ? zc : S1);
        }
        if (sample && t == 32) {
#pragma unroll
          for (int r = 0; r < 16; ++r) { if (r >= 8) S0[r] = -1e30f; S1[r] = -1e30f; }
        }
      };
      auto sm8 = [&](const f32x16& Sx, int r0, float nm, float& lsum) -> bf16x8 {
        f32x2 c2; c2[0] = cexp; c2[1] = cexp;
        f32x2 nm2; nm2[0] = nm; nm2[1] = nm;
        union { u32x4 u; bf16x8 b; } x;
        f32x2 sum2; sum2[0] = 0.f; sum2[1] = 0.f;
#pragma unroll
        for (int r = 0; r < 8; r += 2) {
          f32x2 v; v[0] = Sx[r0 + r]; v[1] = Sx[r0 + r + 1];
          v = v * c2 + nm2;
          f32x2 ex; ex[0] = __builtin_amdgcn_exp2f(v[0]); ex[1] = __builtin_amdgcn_exp2f(v[1]);
          sum2 += ex;
          x.u[r >> 1] = pk2(ex[0], ex[1]);
        }
        lsum += sum2[0] + sum2[1];
        return x.b;
      };
      qk(0);
      pf[0][0] = sm8(S0, 0, nmc[0], ls[0]); pf[0][1] = sm8(S0, 8, nmc[0], ls[0]);
      pf[0][2] = sm8(S1, 0, nmc[0], ls[0]); pf[0][3] = sm8(S1, 8, nmc[0], ls[0]);
      qk(1);
      if (!SAMPLE || t + 1 < ntiles) gloadV(tn);
#pragma unroll
      for (int sl = 0; sl < 4; ++sl) {
#pragma unroll
        for (int e = 0; e < 4; ++e) {
          const bf16x8 vf = tr8(Vs, AV_B, sl * 16, e * 32, lane);
          O1[e] = mfma32(vf, pf[0][sl], O1[e]);
        }
        pf[1][sl] = sm8(sl < 2 ? S0 : S1, (sl & 1) * 8, nmc[1], ls[1]);
      }
#pragma unroll
      for (int sl = 0; sl < 4; ++sl)
#pragma unroll
        for (int e = 0; e < 4; ++e) {
          const bf16x8 vf = tr8(Vs, AV_B, sl * 16, e * 32, lane);
          O2[e] = mfma32(vf, pf[1][sl], O2[e]);
        }
    }
    if (t >= my_tiles && (!SAMPLE || t + 1 < ntiles)) gloadV(tn);
    if (!SAMPLE || t + 1 < ntiles) lwrite((t + 1) & 1);
    __syncthreads();
  }
  if (my_tiles > 0) {
    const float l1 = ls[0] + shx(ls[0], 32, lane), l2 = ls[1] + shx(ls[1], 32, lane);
    const float i1 = 1.f / l1, i2 = lam / l2;
    float s = 0.f;
#pragma unroll
    for (int e = 0; e < 4; ++e)
#pragma unroll
      for (int r = 0; r < 16; ++r) { const float o = O1[e][r] * i1 - O2[e][r] * i2; O1[e][r] = o; s += o * o; }
    s += shx(s, 32, lane);
    const float rs = rsqrtf(s * (1.f / 128.f) + EPS) * (1.f - lam_init);
    const float* g = p.in[24] + layer * 128;
    const bool valid = !sample || lr < 16;
    if (valid) {
      bf16_t* orow = (bf16_t*)(ws + W_MIX) + (size_t)qrow * DM + 512 + head * 128;
#pragma unroll
      for (int e = 0; e < 4; ++e)
#pragma unroll
        for (int gq = 0; gq < 4; ++gq) {
          const int ee = e * 32 + 8 * gq + 4 * hh;
          const f32x4 gv = *(const f32x4*)(g + ee);
          u32x2 pk; pk[0] = pk2(O1[e][4 * gq] * rs * gv[0], O1[e][4 * gq + 1] * rs * gv[1]); pk[1] = pk2(O1[e][4 * gq + 2] * rs * gv[2], O1[e][4 * gq + 3] * rs * gv[3]);
          *(u32x2*)(orow + ee) = pk;
        }
    }
  }
}

DEV void final_norm_phase(CParams& p, int vb, int nb, const int swave) {
  const int lane = ltid() & 63, w = ltid() >> 6;
  const float* ssq = (const float*)(p.ws + W_SSQ);
  const float* g = p.in[29];
  for (int m = vb * 4 + w; m < MTOK; m += nb * 4) {
    const float rs = rscale_of(ssq, m);
    float* row = p.out + (size_t)m * DM;
#pragma unroll
    for (int i = 0; i < 4; ++i) {
      const int c = i * 256 + lane * 4;
      f32x4 v = *(const f32x4*)(row + c); const f32x4 gv = *(const f32x4*)(g + c);
      v[0] *= rs * gv[0]; v[1] *= rs * gv[1]; v[2] *= rs * gv[2]; v[3] *= rs * gv[3];
      *(f32x4*)(row + c) = v;
    }
  }
}

struct LamInit { float v[4]; };

DEV void grid_barrier(unsigned* bar, unsigned target, const int swave) {
  asm volatile("s_waitcnt vmcnt(0)" ::: "memory");
  __syncthreads();
  if (ltid() == 0) {
    __builtin_amdgcn_fence(__ATOMIC_RELEASE, "agent");
    asm volatile("s_waitcnt vmcnt(0)" ::: "memory");
    __hip_atomic_fetch_add(bar, 1u, __ATOMIC_RELAXED, __HIP_MEMORY_SCOPE_AGENT);
    while (__hip_atomic_load(bar, __ATOMIC_RELAXED, __HIP_MEMORY_SCOPE_AGENT) < target) __builtin_amdgcn_s_sleep(2);
    __builtin_amdgcn_fence(__ATOMIC_ACQUIRE, "agent");
    asm volatile("s_waitcnt vmcnt(0)" ::: "memory");
  }
  __syncthreads();
}

DEV CParams* get_params() {
  CParams* q = (CParams*)__builtin_amdgcn_kernarg_segment_ptr();
  asm volatile("" : "+s"(q));
  return q;
}

__global__ void __launch_bounds__(256) fwd_megakernel(Params p_unused, LamInit li) {
  extern __shared__ __attribute__((aligned(16))) char lds[];
  cg::grid_group grid = cg::this_grid();
  const int swave = __builtin_amdgcn_readfirstlane((int)(threadIdx.x >> 6));
  const int nb = gridDim.x;
  const int vb = (nb % 8 == 0) ? (blockIdx.x % 8) * (nb / 8) + blockIdx.x / 8 : blockIdx.x;
  __shared__ int s_unit;
  {
    CParams& p = *get_params();
    prologue_phase(p, lds, vb, nb, swave);
    grid_barrier((unsigned*)(p.ws + W_CTR) + 640, (unsigned)nb, swave);
    if (nb == 0x7fffffff) grid.sync();
  }

  for (int lp = 0; lp < DEPTH * 7; ++lp) {
    const int layer = lp / 7, ph = lp % 7;
    CParams& p = *get_params();
    char* ws = p.ws;
    if (ph == 0) {
      for (int rep = 0; rep < PROBE_GEMM; ++rep)
      gemm_phase<EPI_IN>(p, layer, (const bf16_t*)(ws + W_XBF), DM, (const bf16_t*)(ws + W_WTIN) + (size_t)layer * NIN * DM, DM, NIN / 256, lds, vb, nb, swave);
      if (nb == 256) { for (int u = vb - 128; u >= 0 && u < 512; u += 128) cache_conv_unit(p, layer, u, swave); }
      else { for (int u = vb; u < 512; u += nb) cache_conv_unit(p, layer, u, swave); }
    } else if (ph == 1 || ph == 3) {
      for (int rep = 0; rep < PROBE_CHUNK; ++rep)
      for (int u = vb; u < 512; u += nb) { if (ph == 1) chunk_unit<0>(p, layer, u >> 8, u & 255, lds, swave); else chunk_unit<1>(p, layer, u >> 8, u & 255, lds, swave); }
    } else if (ph == 2) {
      const float* lv = p.in[23] + layer * 256;
      float d1 = 0.f, d2 = 0.f;
      const int lane = ltid() & 63;
      { const int l6 = lane; d1 = lv[l6] * lv[64 + l6]; d2 = lv[128 + l6] * lv[192 + l6]; }
#pragma unroll
      for (int o = 32; o >= 1; o >>= 1) { d1 += shx(d1, o, lane); d2 += shx(d2, o, lane); }
      const float lam = fexp(d1) - fexp(d2) + li.v[layer];
      constexpr int NSCAN = 42, NATT = 32 + 1024;
      for (int rep = 0; rep < PROBE_ATT; ++rep)
      for (;;) {
        __syncthreads();
        if (ltid() == 0) s_unit = (int)atomicAdd((unsigned*)(ws + W_CTR) + layer * 16 + rep * 4, 1u);
        __syncthreads();
        const int u = __builtin_amdgcn_readfirstlane(s_unit) + (rep ? NSCAN : 0);
        if (u >= NSCAN + NATT) break;
        if (u < 32) ssd_scan_unit(p, layer, u, swave);
        else if (u < 34) lru_scan_unit(p, layer, u - 32, swave);
        else if (u < 42) chunk_unit<2>(p, layer, u - 34, 0, lds, swave);
        else if (u - NSCAN < 32) attn_unit<true>(p, layer, u - NSCAN, lam, li.v[layer], lds, swave);
        else attn_unit<false>(p, layer, u - NSCAN, lam, li.v[layer], lds, swave);
      }
    } else if (ph == 4 || ph == 6) {
      const bf16_t* A = (const bf16_t*)(ws + (ph == 4 ? W_MIX : W_U));
      const bf16_t* Bt = ph == 4 ? (const bf16_t*)(ws + W_WTOUT) + (size_t)layer * DM * DM : (const bf16_t*)(ws + W_WTDN) + (size_t)layer * DM * DFF;
      const int K = ph == 4 ? DM : DFF;
      gemm_phase<EPI_RES>(p, layer, A, K, Bt, K, DM / 256, lds, vb, nb, swave);
    } else {
      for (int rep = 0; rep < PROBE_GEMM; ++rep)
      gemm_phase<EPI_UP>(p, layer, (const bf16_t*)(ws + W_XBF), DM, (const bf16_t*)(ws + W_WTUP) + (size_t)layer * DFF * DM, DM, DFF / 256, lds, vb, nb, swave);
    }
    grid_barrier((unsigned*)(ws + W_CTR) + 512, (unsigned)(lp + 1) * (unsigned)nb, swave);
  }
  {
    CParams& p = *get_params();
    final_norm_phase(p, vb, nb, swave);
  }
}

extern "C" void kernel_launch(void* const* d_in, const int* in_sizes, int n_in, void* d_out, int out_size, void* d_ws, size_t ws_size, hipStream_t stream) {
  static int grid_blocks = 0;
  if (!grid_blocks) {
    int dev = 0, cus = 0, per_cu = 0;
    (void)hipGetDevice(&dev);
    (void)hipDeviceGetAttribute(&cus, hipDeviceAttributeMultiprocessorCount, dev);
    (void)hipFuncSetAttribute((const void*)fwd_megakernel, hipFuncAttributeMaxDynamicSharedMemorySize, LDS_BYTES);
    (void)hipOccupancyMaxActiveBlocksPerMultiprocessor(&per_cu, fwd_megakernel, 256, LDS_BYTES);
    if (per_cu < 1) per_cu = 1;
    if (per_cu > 1) per_cu = 1;
    grid_blocks = cus * per_cu;
  }
  Params p;
  memset(&p, 0, sizeof(p));
  for (int i = 0; i < 30; ++i) p.in[i] = (const float*)d_in[i];
  p.out = (float*)d_out;
  p.ws = (char*)d_ws;
  LamInit li;
  for (int l = 0; l < 4; ++l) li.v[l] = (float)(0.8 - 0.6 * exp(-0.3 * (double)l));
  void* args[] = {&p, &li};
  (void)hipMemsetAsync((char*)d_ws + W_CTR, 0, 4096, stream);
  hipError_t e = hipLaunchCooperativeKernel((void*)fwd_megakernel, dim3(grid_blocks), dim3(256), args, LDS_BYTES, stream);
  if (e != hipSuccess) fprintf(stderr, "cooperative launch failed: %s (grid %d)\n", hipGetErrorString(e), grid_blocks);
}
```

```cpp
#include <hip/hip_runtime.h>
#include <hip/hip_cooperative_groups.h>
#include <stdint.h>
#include <stdio.h>
#include <string.h>
#include <math.h>
namespace cg = cooperative_groups;

typedef unsigned short bf16_t;
typedef short bf16x8 __attribute__((ext_vector_type(8)));
typedef short s16x4 __attribute__((ext_vector_type(4)));
typedef float f32x16 __attribute__((ext_vector_type(16)));
typedef float f32x4 __attribute__((ext_vector_type(4)));
typedef unsigned u32x4 __attribute__((ext_vector_type(4)));
typedef unsigned u32x2 __attribute__((ext_vector_type(2)));
typedef float f32x2 __attribute__((ext_vector_type(2)));
#define DEV __device__ __forceinline__
#define LAS __attribute__((address_space(3)))

constexpr int TP = 32768, TS = 128, MTOK = TP + TS;
constexpr int DM = 1024, DFF = 4096, DEPTH = 4;
constexpr int PW = 3072;
constexpr int NIN = 3328;
constexpr int C_GATE = 0, C_XR = 256, C_Z = 512, C_XBC = 768, C_Q = 1536, C_K = 2048, C_V = 2560;
constexpr int NPART = 8;
constexpr float EPS = 1e-6f;

constexpr size_t O_YP = 0;
constexpr size_t O_YS = O_YP + (size_t)TP * DM;
constexpr size_t O_KP = O_YS + (size_t)TS * DM;
constexpr size_t O_VP = O_KP + (size_t)DEPTH * TP * 512;
constexpr size_t O_LCP = O_VP + (size_t)DEPTH * TP * 512;
constexpr size_t O_LHP = O_LCP + (size_t)DEPTH * 2 * 3 * 256;
constexpr size_t O_SCP = O_LHP + (size_t)DEPTH * 2 * 256;
constexpr size_t O_SHP = O_SCP + (size_t)DEPTH * 2 * 3 * 768;
constexpr size_t O_KS = O_SHP + (size_t)DEPTH * 2 * 4 * 64 * 128;
constexpr size_t O_VS = O_KS + (size_t)DEPTH * TS * 512;
constexpr size_t O_LCS = O_VS + (size_t)DEPTH * TS * 512;
constexpr size_t O_LHS = O_LCS + (size_t)DEPTH * 8 * 3 * 256;
constexpr size_t O_SCS = O_LHS + (size_t)DEPTH * 8 * 256;
constexpr size_t O_SHS = O_SCS + (size_t)DEPTH * 8 * 3 * 768;

constexpr size_t AL(size_t x) { return (x + 255) & ~(size_t)255; }
constexpr size_t W_CTR = 0;
constexpr size_t W_WTIN = 4096;
constexpr size_t W_WTOUT = W_WTIN + AL((size_t)DEPTH * NIN * DM * 2);
constexpr size_t W_WTUP = W_WTOUT + AL((size_t)DEPTH * DM * DM * 2);
constexpr size_t W_WTDN = W_WTUP + AL((size_t)DEPTH * DFF * DM * 2);
constexpr size_t W_WAT = W_WTDN + AL((size_t)DEPTH * DFF * DM * 2);
constexpr size_t W_WXT = W_WAT + AL((size_t)DEPTH * 4 * 64 * 64 * 2);
constexpr size_t W_XBF = W_WXT + AL((size_t)DEPTH * 4 * 64 * 64 * 2);
constexpr size_t W_SSQ = W_XBF + AL((size_t)MTOK * DM * 2);
constexpr size_t W_SSDS = W_SSQ + AL((size_t)MTOK * NPART * 4);
constexpr size_t W_SSDDEC = W_SSDS + AL((size_t)2 * 256 * 4 * 64 * 128 * 2);
constexpr size_t W_LRUA = W_SSDDEC + AL((size_t)2 * 256 * 4 * 4);
constexpr size_t W_LRUB = W_LRUA + AL((size_t)2 * 256 * 256 * 4);
constexpr size_t W_PROJ = W_LRUB + AL((size_t)2 * 256 * 256 * 4);
constexpr size_t W_DTRAW = W_PROJ + AL((size_t)MTOK * PW * 2);
constexpr size_t W_KC = W_DTRAW + AL((size_t)MTOK * 4 * 4);
constexpr size_t W_VC = W_KC + AL((size_t)8 * 2048 * 512 * 2);
constexpr size_t W_MIX = W_VC + AL((size_t)8 * 2048 * 512 * 2);
constexpr size_t W_END = W_MIX + AL((size_t)MTOK * DM * 2);
constexpr size_t W_LHL = W_END;
constexpr size_t W_LCA = W_LHL + AL((size_t)MTOK * 256 * 2);
constexpr size_t W_END2 = W_LCA + AL((size_t)MTOK * 256 * 2);
constexpr size_t W_U = W_PROJ;
static_assert(W_U + (size_t)MTOK * DFF * 2 <= W_END, "U overlay");

constexpr int LDS_BYTES = 155 * 1024;
#ifndef PROBE_ATT
#define PROBE_ATT 1
#endif
#ifndef PROBE_GEMM
#define PROBE_GEMM 1
#endif
#ifndef PROBE_CHUNK
#define PROBE_CHUNK 1
#endif

struct Params {
  const float* in[30];
  float* out;
  char* ws;
};
typedef const __attribute__((address_space(4))) Params CParams;

typedef __bf16 bf16v2 __attribute__((ext_vector_type(2)));
DEV uint32_t pk2(float lo, float hi) { f32x2 v; v[0] = lo; v[1] = hi; bf16v2 b = __builtin_convertvector(v, bf16v2); return __builtin_bit_cast(uint32_t, b); }
DEV float bflo(uint32_t u) { return __uint_as_float(u << 16); }
DEV float bfhi(uint32_t u) { return __uint_as_float(u & 0xffff0000u); }
DEV float bf2f(bf16_t b) { return __uint_as_float((uint32_t)b << 16); }
DEV bf16_t f2bf(float f) { return (bf16_t)(pk2(f, 0.f) & 0xffffu); }
DEV float fexp(float x) { return __builtin_amdgcn_exp2f(x * 1.4426950408889634f); }
DEV float flog(float x) { return __builtin_amdgcn_logf(x) * 0.6931471805599453f; }
DEV float frcp(float x) { return __builtin_amdgcn_rcpf(x); }
DEV float sigmoidf_(float x) { return frcp(1.f + fexp(-x)); }
DEV float siluf_(float x) { return x * frcp(1.f + fexp(-x)); }
DEV float softplusf_(float x) { return x > 20.f ? x : flog(1.f + fexp(x)); }
DEV float geluf_(float x) { const float u = 0.7978845608028654f * (x + 0.044715f * x * x * x); const float t = 1.f - 2.f * frcp(1.f + fexp(2.f * u)); return 0.5f * x * (1.f + t); }
DEV float neg_expm1(float y) { return y > -0.05f ? -y * (1.f + y * (0.5f + y * (0.16666667f + y * 0.041666668f))) : 1.f - fexp(y); }
DEV f32x16 mfma32(bf16x8 a, bf16x8 b, f32x16 c) { return __builtin_amdgcn_mfma_f32_32x32x16_bf16(a, b, c, 0, 0, 0); }
DEV f32x16 zero16() { float zz = 0.f; asm volatile("" : "+v"(zz)); f32x16 z; for (int i = 0; i < 16; ++i) z[i] = zz; return z; }
DEV bf16x8 lds_read8(const char* p) { return *(const bf16x8*)p; }
DEV bf16x8 tr8(const char* base, int stride, int r0, int c0, int lane) {
  const int gi = lane >> 4, q = (lane & 15) >> 2, pp = lane & 3;
  const char* a = base + (r0 + 4 * (gi >> 1) + q) * stride + (c0 + 16 * (gi & 1) + 4 * pp) * 2;
  s16x4 lo = __builtin_amdgcn_ds_read_tr16_b64_v4i16((LAS s16x4*)(a));
  s16x4 hi = __builtin_amdgcn_ds_read_tr16_b64_v4i16((LAS s16x4*)(a + 8 * stride));
  bf16x8 r; r[0] = lo[0]; r[1] = lo[1]; r[2] = lo[2]; r[3] = lo[3]; r[4] = hi[0]; r[5] = hi[1]; r[6] = hi[2]; r[7] = hi[3];
  return r;
}
DEV bf16x8 pack8(float a0, float a1, float a2, float a3, float a4, float a5, float a6, float a7) {
  union { u32x4 u; bf16x8 b; } x; x.u[0] = pk2(a0, a1); x.u[1] = pk2(a2, a3); x.u[2] = pk2(a4, a5); x.u[3] = pk2(a6, a7); return x.b;
}
DEV int ltid_(int swave) { int z = 0; asm volatile("" : "+v"(z)); return (swave << 6) | (int)__builtin_amdgcn_mbcnt_hi(~0u, __builtin_amdgcn_mbcnt_lo(~0u, (unsigned)z)); }
#define ltid() ltid_(swave)
DEV float shx(float v, int o, int lane) { return __builtin_bit_cast(float, __builtin_amdgcn_ds_bpermute((lane ^ o) << 2, __builtin_bit_cast(int, v))); }
DEV float rscale_of(const float* ssq, int m) {
  const f32x4 a = *(const f32x4*)(ssq + (size_t)m * NPART), b = *(const f32x4*)(ssq + (size_t)m * NPART + 4);
  const float s = (a[0] + a[1]) + (a[2] + a[3]) + (b[0] + b[1]) + (b[2] + b[3]);
  return rsqrtf(s * (1.f / DM) + EPS);
}

DEV void wt_tile(const float* src, int ldsrc, bf16_t* dst, int lddst, int k0, int n0, const float* g, bool inmap, char* lds, const int swave) {
  float (*T)[65] = (float (*)[65])lds;
  const int tid = ltid();
  {
    const int kr = tid >> 4, nq = tid & 15;
    const int nn = n0 + nq * 4;
    int sn = nn;
    if (inmap) { sn = nn < 1536 ? nn : (nn < 3072 ? nn + 4 : (nn < 3076 ? nn - 3072 + 1536 : -1)); }
    f32x4 v[4];
#pragma unroll
    for (int i = 0; i < 4; ++i) {
      const int k = kr + 16 * i;
      if (sn >= 0) v[i] = *(const f32x4*)(src + (size_t)(k0 + k) * ldsrc + sn); else { v[i][0] = 0.f; v[i][1] = 0.f; v[i][2] = 0.f; v[i][3] = 0.f; }
    }
#pragma unroll
    for (int i = 0; i < 4; ++i) {
      const int k = kr + 16 * i;
      const float gg = g ? g[k0 + k] : 1.f;
      T[k][nq * 4 + 0] = v[i][0] * gg; T[k][nq * 4 + 1] = v[i][1] * gg; T[k][nq * 4 + 2] = v[i][2] * gg; T[k][nq * 4 + 3] = v[i][3] * gg;
    }
  }
  __syncthreads();
  {
    const int n = tid & 63, kq = tid >> 6;
#pragma unroll
    for (int i = 0; i < 2; ++i) {
      const int kk = (kq + 4 * i) * 8;
      u32x4 o;
      o[0] = pk2(T[kk][n], T[kk + 1][n]); o[1] = pk2(T[kk + 2][n], T[kk + 3][n]); o[2] = pk2(T[kk + 4][n], T[kk + 5][n]); o[3] = pk2(T[kk + 6][n], T[kk + 7][n]);
      *(u32x4*)(dst + (size_t)(n0 + n) * lddst + k0 + kk) = o;
    }
  }
  __syncthreads();
}

DEV void prologue_phase(CParams& p, char* lds, int vb, int nb, const int swave) {
  char* ws = p.ws;

  constexpr int T_IN = 16 * (NIN / 64), T_OUT = 16 * 16, T_UP = 16 * 64, T_DN = 64 * 16, T_G = 8;
  constexpr int T_L = T_IN + T_OUT + T_UP + T_DN + T_G;
  for (int u = vb; u < DEPTH * T_L; u += nb) {
    const int l = u / T_L; int r = u % T_L;
    if (r < T_IN) { const int kt = r % 16, nt = r / 16;
      wt_tile(p.in[9] + (size_t)l * DM * 3076, 3076, (bf16_t*)(ws + W_WTIN) + (size_t)l * NIN * DM, DM, kt * 64, nt * 64, p.in[8] + l * DM, true, lds, swave);
    } else if ((r -= T_IN) < T_OUT) { const int kt = r % 16, nt = r / 16;
      wt_tile(p.in[25] + (size_t)l * DM * DM, DM, (bf16_t*)(ws + W_WTOUT) + (size_t)l * DM * DM, DM, kt * 64, nt * 64, nullptr, false, lds, swave);
    } else if ((r -= T_OUT) < T_UP) { const int kt = r % 16, nt = r / 16;
      wt_tile(p.in[27] + (size_t)l * DM * DFF, DFF, (bf16_t*)(ws + W_WTUP) + (size_t)l * DFF * DM, DM, kt * 64, nt * 64, p.in[26] + l * DM, false, lds, swave);
    } else if ((r -= T_UP) < T_DN) { const int kt = r % 64, nt = r / 64;
      wt_tile(p.in[28] + (size_t)l * DFF * DM, DM, (bf16_t*)(ws + W_WTDN) + (size_t)l * DM * DFF, DFF, kt * 64, nt * 64, nullptr, false, lds, swave);
    } else { r -= T_DN; const int h = r & 3, which = r >> 2;
      wt_tile(p.in[which ? 14 : 12] + (size_t)(l * 4 + h) * 4096, 64, (bf16_t*)(ws + (which ? W_WXT : W_WAT)) + (size_t)(l * 4 + h) * 4096, 64, 0, 0, nullptr, false, lds, swave);
    }
  }
  const int lane = ltid() & 63, w = ltid() >> 6;
  float* xo = p.out; bf16_t* xbf = (bf16_t*)(ws + W_XBF); float* ssq = (float*)(ws + W_SSQ);
  for (int m = vb * 4 + w; m < MTOK; m += nb * 4) {
    const float* src = m < TP ? p.in[0] + (size_t)m * DM : p.in[1] + (size_t)(m - TP) * DM;
    float s = 0.f;
#pragma unroll
    for (int i = 0; i < 4; ++i) {
      const int c = i * 256 + lane * 4;
      const f32x4 v = *(const f32x4*)(src + c);
      *(f32x4*)(xo + (size_t)m * DM + c) = v;
      u32x2 pk; pk[0] = pk2(v[0], v[1]); pk[1] = pk2(v[2], v[3]);
      *(u32x2*)(xbf + (size_t)m * DM + c) = pk;
      s += v[0] * v[0] + v[1] * v[1] + v[2] * v[2] + v[3] * v[3];
    }
#pragma unroll
    for (int o = 32; o >= 1; o >>= 1) s += shx(s, o, lane);
    if (lane < NPART) ssq[(size_t)m * NPART + lane] = lane == 0 ? s : 0.f;
  }
}

constexpr int GS_B = 144;
constexpr int G_TILE = 256 * GS_B;
enum { EPI_IN = 0, EPI_RES = 1, EPI_UP = 2 };

template <int EPI>
DEV void gemm_tile(CParams& p, int layer, const bf16_t* __restrict__ A, int lda, const bf16_t* __restrict__ Bt, int K, int m0, int n0, int nt, char* lds, const int swave) {
  const int tid = ltid(), lane = tid & 63, w = __builtin_amdgcn_readfirstlane(tid >> 6), wm = w >> 1, wn = w & 1, lr = lane & 31, hh = lane >> 5;
  const int lrow = tid >> 3, lch = tid & 7;
  f32x16 acc[4][4];
#pragma unroll
  for (int j = 0; j < 4; ++j)
#pragma unroll
    for (int i = 0; i < 4; ++i) acc[j][i] = zero16();
  u32x4 ra0[8], rb0[8], ra1[8], rb1[8];
  const int nk = K / 64;
  const char* abase = (const char*)(A + (size_t)m0 * lda);
  const char* bbase = (const char*)(Bt + (size_t)n0 * K);
  const unsigned aoff = (unsigned)(lrow * lda + lch * 8) * 2u;
  const unsigned boff = (unsigned)(lrow * K + lch * 8) * 2u;
  const bool tail = m0 + 256 > MTOK;
#define GLOAD(RA, RB, kt) { _Pragma("unroll") for (int i = 0; i < 8; ++i) { const int ia = (tail && i >= 4) ? i - 4 : i; \
    RA[i] = *(const u32x4*)(abase + ((size_t)(32 * ia) * lda + (kt) * 64) * 2 + aoff); RB[i] = *(const u32x4*)(bbase + ((size_t)(32 * i) * K + (kt) * 64) * 2 + boff); } }
#define LWRITE(RA, RB, buf) { char* as_ = lds + (buf) * 2 * G_TILE; char* bs_ = as_ + G_TILE; _Pragma("unroll") for (int i = 0; i < 8; ++i) { *(u32x4*)(as_ + (lrow + 32 * i) * GS_B + lch * 16) = RA[i]; *(u32x4*)(bs_ + (lrow + 32 * i) * GS_B + lch * 16) = RB[i]; } }
  const char* asr = lds + (wm * 128 + lr) * GS_B + hh * 16;
  const char* bsr = lds + G_TILE + (wn * 128 + lr) * GS_B + hh * 16;
  char* wsw = lds + lrow * GS_B + lch * 16;
#define WR2(RA, RB, wbuf, i0) { _Pragma("unroll") for (int i = (i0); i < (i0) + 2; ++i) { \
    *(u32x4*)(wsw + (wbuf) * 2 * G_TILE + (32 * i) * GS_B) = RA[i]; *(u32x4*)(wsw + (wbuf) * 2 * G_TILE + G_TILE + (32 * i) * GS_B) = RB[i]; } }
#define COMPUTE(rbuf, RA, RB, wbuf, dowrite) { \
    _Pragma("unroll 2") for (int ks = 0; ks < 4; ++ks) { \
      bf16x8 af[4], bf[4]; \
      _Pragma("unroll") for (int i = 0; i < 4; ++i) { af[i] = lds_read8(asr + (rbuf) * 2 * G_TILE + i * 32 * GS_B + ks * 32); bf[i] = lds_read8(bsr + (rbuf) * 2 * G_TILE + i * 32 * GS_B + ks * 32); } \
      _Pragma("unroll") for (int j = 0; j < 4; ++j) _Pragma("unroll") for (int i = 0; i < 4; ++i) acc[j][i] = mfma32(bf[j], af[i], acc[j][i]); \
      if (dowrite) { if (ks == 0) WR2(RA, RB, wbuf, 0) else if (ks == 1) WR2(RA, RB, wbuf, 2) else if (ks == 2) WR2(RA, RB, wbuf, 4) else WR2(RA, RB, wbuf, 6) } \
    } }
  GLOAD(ra0, rb0, 0); GLOAD(ra1, rb1, 1); LWRITE(ra0, rb0, 0); __syncthreads();
#pragma unroll 1
  for (int kt = 0; kt < nk; kt += 2) {
    if (kt + 2 < nk) GLOAD(ra0, rb0, kt + 2);
    COMPUTE(0, ra1, rb1, 1, true);
    __syncthreads();
    const bool more = kt + 2 < nk;
    if (kt + 3 < nk) GLOAD(ra1, rb1, kt + 3);
    COMPUTE(1, ra0, rb0, 0, more);
    __syncthreads();
  }
#undef COMPUTE
#undef WR2
#undef GLOAD
#undef LWRITE
  char* ws = p.ws;
  const float* ssq = (const float*)(ws + W_SSQ);
  if (!(tail && wm == 1)) {
#pragma unroll
  for (int i = 0; i < 4; ++i) {
    const int mc = m0 + wm * 128 + i * 32 + lr;
    if (EPI == EPI_IN) {
      const float rs = rscale_of(ssq, mc);
      if (nt < 12) {
        bf16_t* prow = (bf16_t*)(ws + W_PROJ) + (size_t)mc * PW;
        float* fo = nullptr;
        if (nt >= 8) {
          const int cc = nt >= 10 ? 1 : 0;
          if (mc < TP) fo = p.out + (cc ? O_VP : O_KP) + ((size_t)layer * TP + mc) * 512 - (cc ? C_V : C_K);
          else fo = p.out + (cc ? O_VS : O_KS) + ((size_t)layer * TS + (mc - TP)) * 512 - (cc ? C_V : C_K);
        }
#pragma unroll
        for (int j = 0; j < 4; ++j)
#pragma unroll
          for (int g = 0; g < 4; ++g) {
            const int n = n0 + wn * 128 + j * 32 + 8 * g + 4 * hh;
            f32x4 v; v[0] = acc[j][i][4 * g] * rs; v[1] = acc[j][i][4 * g + 1] * rs; v[2] = acc[j][i][4 * g + 2] * rs; v[3] = acc[j][i][4 * g + 3] * rs;
            u32x2 pk; pk[0] = pk2(v[0], v[1]); pk[1] = pk2(v[2], v[3]);
            *(u32x2*)(prow + n) = pk;
            if (nt >= 8) *(f32x4*)(fo + n) = v;
          }
      } else {
        if (wn == 0 && hh == 0) {
          f32x4 v; v[0] = acc[0][i][0] * rs; v[1] = acc[0][i][1] * rs; v[2] = acc[0][i][2] * rs; v[3] = acc[0][i][3] * rs;
          *(f32x4*)((float*)(ws + W_DTRAW) + (size_t)mc * 4) = v;
        }
      }
    } else if (EPI == EPI_RES) {
      float* __restrict__ xrow = p.out + (size_t)mc * DM + n0 + wn * 128 + 4 * hh;
      bf16_t* __restrict__ brow = (bf16_t*)(ws + W_XBF) + (size_t)mc * DM + n0 + wn * 128 + 4 * hh;
      f32x4 xv[16];
#pragma unroll
      for (int q = 0; q < 16; ++q) xv[q] = *(const f32x4*)(xrow + (q >> 2) * 32 + (q & 3) * 8);
      float s = 0.f;
#pragma unroll
      for (int j = 0; j < 4; ++j)
#pragma unroll
        for (int g = 0; g < 4; ++g) {
          f32x4 v = xv[j * 4 + g];
          v[0] += acc[j][i][4 * g]; v[1] += acc[j][i][4 * g + 1]; v[2] += acc[j][i][4 * g + 2]; v[3] += acc[j][i][4 * g + 3];
          s += v[0] * v[0] + v[1] * v[1] + v[2] * v[2] + v[3] * v[3];
          *(f32x4*)(xrow + j * 32 + g * 8) = v;
          u32x2 pk; pk[0] = pk2(v[0], v[1]); pk[1] = pk2(v[2], v[3]);
          *(u32x2*)(brow + j * 32 + g * 8) = pk;
        }
      s += shx(s, 32, lane);
      if (hh == 0) ((float*)(ws + W_SSQ))[(size_t)mc * NPART + nt * 2 + wn] = s;
    } else {
      const float rs = rscale_of(ssq, mc);
      bf16_t* urow = (bf16_t*)(ws + W_U) + (size_t)mc * DFF;
#pragma unroll
      for (int j = 0; j < 4; ++j)
#pragma unroll
        for (int g = 0; g < 4; ++g) {
          const int n = n0 + wn * 128 + j * 32 + 8 * g + 4 * hh;
          float v0 = fmaxf(acc[j][i][4 * g] * rs, 0.f), v1 = fmaxf(acc[j][i][4 * g + 1] * rs, 0.f), v2 = fmaxf(acc[j][i][4 * g + 2] * rs, 0.f), v3 = fmaxf(acc[j][i][4 * g + 3] * rs, 0.f);
          u32x2 pk; pk[0] = pk2(v0 * v0, v1 * v1); pk[1] = pk2(v2 * v2, v3 * v3);
          *(u32x2*)(urow + n) = pk;
        }
    }
  }
  }
}

constexpr int GM_T = 128 * GS_B;
template <int EPI>
DEV void gemm_mini(CParams& p, int layer, const bf16_t* __restrict__ A, int lda, const bf16_t* __restrict__ Bt, int K, int n0, char* lds, const int swave) {
  const int tid = ltid(), lane = tid & 63, w = swave, lr = lane & 31, hh = lane >> 5;
  const int lrow = tid >> 3, lch = tid & 7;
  f32x16 acc[4];
#pragma unroll
  for (int j = 0; j < 4; ++j) acc[j] = zero16();
  u32x4 ra[4][4], rb[4][4];
  const int nk = K / 64;
  const char* abase = (const char*)(A + (size_t)TP * lda);
  const char* bbase = (const char*)(Bt + (size_t)n0 * K);
  const unsigned aoff = (unsigned)(lrow * lda + lch * 8) * 2u, boff = (unsigned)(lrow * K + lch * 8) * 2u;
#define MLOAD(S, kt) { _Pragma("unroll") for (int i = 0; i < 4; ++i) { ra[S][i] = *(const u32x4*)(abase + ((size_t)(32 * i) * lda + (kt) * 64) * 2 + aoff); rb[S][i] = *(const u32x4*)(bbase + ((size_t)(32 * i) * K + (kt) * 64) * 2 + boff); } }
#define MWRITE(S, buf) { char* as_ = lds + (buf) * 2 * GM_T; char* bs_ = as_ + GM_T; _Pragma("unroll") for (int i = 0; i < 4; ++i) { *(u32x4*)(as_ + (lrow + 32 * i) * GS_B + lch * 16) = ra[S][i]; *(u32x4*)(bs_ + (lrow + 32 * i) * GS_B + lch * 16) = rb[S][i]; } }
#define MSTEP(S, kk) { \
    if ((kk) + 4 < nk) MLOAD(S, (kk) + 4) \
    const char* as = lds + ((kk) & 1) * 2 * GM_T + (w * 32 + lr) * GS_B + hh * 16; \
    const char* bs = lds + ((kk) & 1) * 2 * GM_T + GM_T + lr * GS_B + hh * 16; \
    _Pragma("unroll") for (int ks = 0; ks < 4; ++ks) { \
      const bf16x8 af = lds_read8(as + ks * 32); \
      _Pragma("unroll") for (int j = 0; j < 4; ++j) { const bf16x8 bf = lds_read8(bs + j * 32 * GS_B + ks * 32); acc[j] = mfma32(bf, af, acc[j]); } \
    } \
    if ((kk) + 1 < nk) MWRITE(((S) + 1) & 3, ((kk) + 1) & 1) \
    __syncthreads(); }
  MLOAD(0, 0) MLOAD(1, 1) MLOAD(2, 2) MLOAD(3, 3) MWRITE(0, 0) __syncthreads();
#pragma unroll 1
  for (int kt = 0; kt < nk; kt += 4) { MSTEP(0, kt) MSTEP(1, kt + 1) MSTEP(2, kt + 2) MSTEP(3, kt + 3) }
#undef MSTEP
#undef MWRITE
#undef MLOAD
  char* ws = p.ws;
  const float* ssq = (const float*)(ws + W_SSQ);
  const int mc = TP + w * 32 + lr;
  if (EPI == EPI_IN) {
    const float rs = rscale_of(ssq, mc);
    if (n0 < PW) {
      bf16_t* prow = (bf16_t*)(ws + W_PROJ) + (size_t)mc * PW;
      float* fo = nullptr;
      if (n0 >= C_K) { const int cc = n0 >= C_V ? 1 : 0; fo = p.out + (cc ? O_VS : O_KS) + ((size_t)layer * TS + (mc - TP)) * 512 - (cc ? C_V : C_K); }
#pragma unroll
      for (int j = 0; j < 4; ++j)
#pragma unroll
        for (int g = 0; g < 4; ++g) {
          const int n = n0 + j * 32 + 8 * g + 4 * hh;
          f32x4 v; v[0] = acc[j][4 * g] * rs; v[1] = acc[j][4 * g + 1] * rs; v[2] = acc[j][4 * g + 2] * rs; v[3] = acc[j][4 * g + 3] * rs;
          u32x2 pk; pk[0] = pk2(v[0], v[1]); pk[1] = pk2(v[2], v[3]);
          *(u32x2*)(prow + n) = pk;
          if (n0 >= C_K) *(f32x4*)(fo + n) = v;
        }
    } else if (n0 == PW) {
      if (hh == 0) { f32x4 v; v[0] = acc[0][0] * rs; v[1] = acc[0][1] * rs; v[2] = acc[0][2] * rs; v[3] = acc[0][3] * rs; *(f32x4*)((float*)(ws + W_DTRAW) + (size_t)mc * 4) = v; }
    }
  } else if (EPI == EPI_RES) {
    float* __restrict__ xrow = p.out + (size_t)mc * DM + n0 + 4 * hh;
    bf16_t* __restrict__ brow = (bf16_t*)(ws + W_XBF) + (size_t)mc * DM + n0 + 4 * hh;
    f32x4 xv[16];
#pragma unroll
    for (int q = 0; q < 16; ++q) xv[q] = *(const f32x4*)(xrow + (q >> 2) * 32 + (q & 3) * 8);
    float s = 0.f;
#pragma unroll
    for (int j = 0; j < 4; ++j)
#pragma unroll
      for (int g = 0; g < 4; ++g) {
        f32x4 v = xv[j * 4 + g];
        v[0] += acc[j][4 * g]; v[1] += acc[j][4 * g + 1]; v[2] += acc[j][4 * g + 2]; v[3] += acc[j][4 * g + 3];
        s += v[0] * v[0] + v[1] * v[1] + v[2] * v[2] + v[3] * v[3];
        *(f32x4*)(xrow + j * 32 + g * 8) = v;
        u32x2 pk; pk[0] = pk2(v[0], v[1]); pk[1] = pk2(v[2], v[3]);
        *(u32x2*)(brow + j * 32 + g * 8) = pk;
      }
    s += shx(s, 32, lane);
    if (hh == 0) ((float*)(ws + W_SSQ))[(size_t)mc * NPART + (n0 >> 7)] = s;
  } else {
    const float rs = rscale_of(ssq, mc);
    bf16_t* urow = (bf16_t*)(ws + W_U) + (size_t)mc * DFF;
#pragma unroll
    for (int j = 0; j < 4; ++j)
#pragma unroll
      for (int g = 0; g < 4; ++g) {
        const int n = n0 + j * 32 + 8 * g + 4 * hh;
        float v0 = fmaxf(acc[j][4 * g] * rs, 0.f), v1 = fmaxf(acc[j][4 * g + 1] * rs, 0.f), v2 = fmaxf(acc[j][4 * g + 2] * rs, 0.f), v3 = fmaxf(acc[j][4 * g + 3] * rs, 0.f);
        u32x2 pk; pk[0] = pk2(v0 * v0, v1 * v1); pk[1] = pk2(v2 * v2, v3 * v3);
        *(u32x2*)(urow + n) = pk;
      }
  }
}

template <int EPI>
DEV void gemm_phase(CParams& p, int layer, const bf16_t* A, int lda, const bf16_t* Bt, int K, int NT, char* lds, int vb, int nb, const int swave) {
  constexpr int MT = TP / 256;
  const int ntiles = MT * NT;
  for (int t = vb; t < ntiles; t += nb) {
    const int grp = t / (8 * NT), r = t - grp * (8 * NT);
    const int mt = grp * 8 + (r & 7), nt = r >> 3;
    gemm_tile<EPI>(p, layer, A, lda, Bt, K, mt * 256, nt * 256, nt, lds, swave);
  }
  const int nmini = EPI == EPI_IN ? (PW + 128) / 128 : NT * 2;
  for (int t = nb - 1 - vb; t < nmini; t += nb) gemm_mini<EPI>(p, layer, A, lda, Bt, K, t * 128, lds, swave);
}

DEV void cache_conv_unit(CParams& p, int layer, int u, const int swave) {
  const int which = u >> 8, uu = u & 255;
  const float* src = p.in[which ? 3 : 2] + (size_t)layer * 8 * 2048 * 512 + (size_t)uu * 32768;
  bf16_t* dst = (bf16_t*)(p.ws + (which ? W_VC : W_KC)) + (size_t)uu * 32768;
#pragma unroll 4
  for (int i = 0; i < 16; ++i) {
    const int e = (i * 256 + ltid()) * 8;
    const f32x4 a = *(const f32x4*)(src + e), b = *(const f32x4*)(src + e + 4);
    u32x4 o; o[0] = pk2(a[0], a[1]); o[1] = pk2(a[2], a[3]); o[2] = pk2(b[0], b[1]); o[3] = pk2(b[2], b[3]);
    *(u32x4*)(dst + e) = o;
  }
}

constexpr int CS_B = 576;
constexpr int SLOT = 64 * CS_B;
constexpr int XR_B = 528;

DEV void chunk_unit(CParams& p, int layer, int mode, int b, int c, char* lds, const int swave) {
  const int tid = ltid(), lane = tid & 63, w = tid >> 6, lr = lane & 31, hh = lane >> 5;
  char* ws = p.ws;
  const int L = mode == 2 ? 16 : 64;
  const int row0 = mode == 2 ? TP + b * 16 : b * 16384 + c * 64;
  const bf16_t* proj = (const bf16_t*)(ws + W_PROJ);
  bf16_t* mixed = (bf16_t*)(ws + W_MIX);
  float* smallf = (float*)(lds + 4 * SLOT);
  float* dtL = smallf, *csL = smallf + 256, *red = smallf + 512, *chc = smallf + 768;

  auto ld_pair = [&](int t, int col, const float* st, int stw) -> uint32_t {
    if (t >= L) return 0u;
    if (t >= 0) return *(const uint32_t*)(proj + (size_t)(row0 + t) * PW + col);
    if (mode == 2) { const float* s = st + (size_t)(3 + t) * stw; return pk2(s[0], s[1]); }
    if (c > 0) return *(const uint32_t*)(proj + (size_t)(row0 + t) * PW + col);
    return 0u;
  };

  {
    const float bias = p.in[19][layer * 4 + w], aneg = -fexp(p.in[20][layer * 4 + w]);
    const int tc = lane < L ? lane : L - 1;
    const float raw = ((const float*)(ws + W_DTRAW))[(size_t)(row0 + tc) * 4 + w];
    const float dtv = lane < L ? softplusf_(raw + bias) : 0.f;
    float cs = dtv * aneg;
#pragma unroll
    for (int o = 1; o < 64; o <<= 1) {
      const float y = __builtin_bit_cast(float, __builtin_amdgcn_ds_bpermute(((lane - o) & 63) << 2, __builtin_bit_cast(int, cs)));
      if (lane >= o) cs += y;
    }
    dtL[lane * 4 + w] = dtv; csL[lane * 4 + w] = cs;
    const int ch = tid;
    chc[ch] = p.in[13][layer * 256 + ch]; chc[256 + ch] = p.in[15][layer * 256 + ch]; chc[512 + ch] = -8.f * softplusf_(-p.in[16][layer * 256 + ch]);
  }
  if (mode == 1) {
    if (c == 255) {
      float* o = p.out + O_LCP + (size_t)(layer * 2 + b) * 768;
      for (int idx = tid; idx < 768; idx += 256) { const int j = idx >> 8, cc = idx & 255; o[idx] = bf2f(proj[(size_t)(row0 + L - 3 + j) * PW + C_XR + cc]); }
    }
    const bf16_t* hl = (const bf16_t*)(ws + W_LHL);
    const bf16_t* ca = (const bf16_t*)(ws + W_LCA);
    const float* hin = (const float*)(ws + W_LRUB) + (size_t)(b * 256 + c) * 256;
#pragma unroll 2
    for (int q = 0; q < 8; ++q) {
      const int it = tid + 256 * q, t2 = it >> 5, cg8 = (it & 31) * 8;
      const u32x4 gv = *(const u32x4*)(proj + (size_t)(row0 + t2) * PW + C_GATE + cg8);
      const u32x4 hv = *(const u32x4*)(hl + (size_t)(row0 + t2) * 256 + cg8);
      const u32x4 cv = *(const u32x4*)(ca + (size_t)(row0 + t2) * 256 + cg8);
      const f32x4 i0 = *(const f32x4*)(hin + cg8), i1 = *(const f32x4*)(hin + cg8 + 4);
      u32x4 o;
      o[0] = pk2(geluf_(bflo(gv[0])) * (bflo(hv[0]) + bflo(cv[0]) * i0[0]), geluf_(bfhi(gv[0])) * (bfhi(hv[0]) + bfhi(cv[0]) * i0[1]));
      o[1] = pk2(geluf_(bflo(gv[1])) * (bflo(hv[1]) + bflo(cv[1]) * i0[2]), geluf_(bfhi(gv[1])) * (bfhi(hv[1]) + bfhi(cv[1]) * i0[3]));
      o[2] = pk2(geluf_(bflo(gv[2])) * (bflo(hv[2]) + bflo(cv[2]) * i1[0]), geluf_(bfhi(gv[2])) * (bfhi(hv[2]) + bfhi(cv[2]) * i1[1]));
      o[3] = pk2(geluf_(bflo(gv[3])) * (bflo(hv[3]) + bflo(cv[3]) * i1[2]), geluf_(bfhi(gv[3])) * (bfhi(hv[3]) + bfhi(cv[3]) * i1[3]));
      *(u32x4*)(mixed + (size_t)(row0 + t2) * DM + cg8) = o;
    }
    __syncthreads();
  } else {
  {
    const int cp = tid & 127, th = tid >> 7, ch = cp * 2;
    const float* cw = p.in[10] + (size_t)layer * 4 * 256;
    const float w00 = cw[ch], w01 = cw[ch + 1], w10 = cw[256 + ch], w11 = cw[256 + ch + 1], w20 = cw[512 + ch], w21 = cw[512 + ch + 1], w30 = cw[768 + ch], w31 = cw[768 + ch + 1];
    const float b0 = p.in[11][layer * 256 + ch], b1 = p.in[11][layer * 256 + ch + 1];
    const float* st = p.in[4] + ((size_t)(layer * 8 + b) * 3) * 256 + ch;
    float x0a = 0, x0b = 0, x1a = 0, x1b = 0, x2a = 0, x2b = 0;
    {
      uint32_t u;
      u = ld_pair(th * 32 - 3, C_XR + ch, st, 256); x0a = bflo(u); x0b = bfhi(u);
      u = ld_pair(th * 32 - 2, C_XR + ch, st, 256); x1a = bflo(u); x1b = bfhi(u);
      u = ld_pair(th * 32 - 1, C_XR + ch, st, 256); x2a = bflo(u); x2b = bfhi(u);
    }
#pragma unroll 8
    for (int tt = 0; tt < 32; ++tt) {
      const int t = th * 32 + tt;
      const uint32_t u = ld_pair(t, C_XR + ch, st, 256);
      const float xa = bflo(u), xb = bfhi(u);
      float oa = b0 + w00 * x0a + w10 * x1a + w20 * x2a + w30 * xa;
      float ob = b1 + w01 * x0b + w11 * x1b + w21 * x2b + w31 * xb;
      if (t >= L) { oa = 0.f; ob = 0.f; }
      *(uint32_t*)(lds + t * XR_B + ch * 2) = pk2(oa, ob);
      x0a = x1a; x0b = x1b; x1a = x2a; x1b = x2b; x2a = xa; x2b = xb;
    }
    if (mode == 2 || (mode == 1 && c == 255)) {
      float* o = p.out + (mode == 2 ? O_LCS + (size_t)(layer * 8 + b) * 768 : O_LCP + (size_t)(layer * 2 + b) * 768);
      for (int idx = tid; idx < 768; idx += 256) { const int j = idx >> 8, cc = idx & 255; o[idx] = bf2f(proj[(size_t)(row0 + L - 3 + j) * PW + C_XR + cc]); }
    }
  }
  __syncthreads();
  {
    float2* AB = (float2*)(lds + SLOT);
    float* Hs = (float*)(lds + 3 * SLOT);
    const bf16_t* wat = (const bf16_t*)(ws + W_WAT) + (size_t)layer * 4 * 4096;
    const bf16_t* wxt = (const bf16_t*)(ws + W_WXT) + (size_t)layer * 4 * 4096;
    for (int pass = 0; pass < 2; ++pass) {
      const int hb = pass * 2 + (w >> 1), ti = w & 1;
      f32x16 ar[2], ai[2];
      ar[0] = zero16(); ar[1] = zero16(); ai[0] = zero16(); ai[1] = zero16();
#pragma unroll
      for (int ks = 0; ks < 4; ++ks) {
        const bf16x8 xf = lds_read8(lds + (ti * 32 + lr) * XR_B + (hb * 64 + ks * 16 + hh * 8) * 2);
#pragma unroll
        for (int jt = 0; jt < 2; ++jt) {
          const size_t wo = (size_t)hb * 4096 + (size_t)(jt * 32 + lr) * 64 + ks * 16 + hh * 8;
          const bf16x8 fa = *(const bf16x8*)(wat + wo), fx = *(const bf16x8*)(wxt + wo);
          ar[jt] = mfma32(fa, xf, ar[jt]); ai[jt] = mfma32(fx, xf, ai[jt]);
        }
      }
      const int t = ti * 32 + lr;
#pragma unroll
      for (int jt = 0; jt < 2; ++jt)
#pragma unroll
        for (int r = 0; r < 16; ++r) {
          const int j = jt * 32 + 8 * (r >> 2) + 4 * hh + (r & 3);
          const int ch = hb * 64 + j;
          const float rg = sigmoidf_(ar[jt][r] + chc[ch]);
          const float ig = sigmoidf_(ai[jt][r] + chc[256 + ch]);
          const float la = rg * chc[512 + ch];
          const float a = fexp(la);
          const float xv = bf2f(*(const bf16_t*)(lds + t * XR_B + ch * 2));
          const float bb = __builtin_amdgcn_sqrtf(fmaxf(neg_expm1(2.f * la), 0.f)) * (ig * xv);
          AB[t * 129 + (w >> 1) * 64 + j] = make_float2(a, bb);
        }
      __syncthreads();
      if (tid < 128) {
        const int ch = pass * 128 + tid;
        float h = 0.f, ap = 1.f;
        if (mode == 1) h = ((const float*)(ws + W_LRUB))[(size_t)(b * 256 + c) * 256 + ch];
        else if (mode == 2) h = p.in[5][(size_t)(layer * 8 + b) * 256 + ch];
        for (int t2 = 0; t2 < L; ++t2) {
          const float2 v = AB[t2 * 129 + tid];
          h = v.x * h + v.y; ap *= v.x;
          Hs[t2 * 128 + tid] = h;
          if (mode == 0) { ((bf16_t*)(ws + W_LHL))[(size_t)(row0 + t2) * 256 + ch] = f2bf(h); ((bf16_t*)(ws + W_LCA))[(size_t)(row0 + t2) * 256 + ch] = f2bf(ap); }
        }
        if (mode == 0) { ((float*)(ws + W_LRUA))[(size_t)(b * 256 + c) * 256 + ch] = ap; ((float*)(ws + W_LRUB))[(size_t)(b * 256 + c) * 256 + ch] = h; }
        if (mode == 2) p.out[O_LHS + (size_t)(layer * 8 + b) * 256 + ch] = h;
      }
      __syncthreads();
      if (mode != 0) {
        for (int it = tid; it < L * 16; it += 256) {
          const int t2 = it >> 4, cg8 = (it & 15) * 8;
          const u32x4 gv = *(const u32x4*)(proj + (size_t)(row0 + t2) * PW + C_GATE + pass * 128 + cg8);
          const f32x4 h0 = *(const f32x4*)(Hs + t2 * 128 + cg8), h1 = *(const f32x4*)(Hs + t2 * 128 + cg8 + 4);
          u32x4 o;
          o[0] = pk2(geluf_(bflo(gv[0])) * h0[0], geluf_(bfhi(gv[0])) * h0[1]);
          o[1] = pk2(geluf_(bflo(gv[1])) * h0[2], geluf_(bfhi(gv[1])) * h0[3]);
          o[2] = pk2(geluf_(bflo(gv[2])) * h1[0], geluf_(bfhi(gv[2])) * h1[1]);
          o[3] = pk2(geluf_(bflo(gv[3])) * h1[2], geluf_(bfhi(gv[3])) * h1[3]);
          *(u32x4*)(mixed + (size_t)(row0 + t2) * DM + pass * 128 + cg8) = o;
        }
        __syncthreads();
      }
    }
  }
  }
  {
    const int npairs = mode == 0 ? 256 : 384;
    const float* cw = p.in[17] + (size_t)layer * 4 * 768;
    const float* cb = p.in[18] + (size_t)layer * 768;
    for (int item = tid; item < npairs * 4; item += 256) {
      const int pr = item % npairs, tq = item / npairs, ch = pr * 2;
      const float w00 = cw[ch], w01 = cw[ch + 1], w10 = cw[768 + ch], w11 = cw[768 + ch + 1], w20 = cw[1536 + ch], w21 = cw[1536 + ch + 1], w30 = cw[2304 + ch], w31 = cw[2304 + ch + 1];
      const float b0 = cb[ch], b1 = cb[ch + 1];
      const float* st = p.in[6] + ((size_t)(layer * 8 + b) * 3) * 768 + ch;
      const int sec = ch >> 8, cl = ch & 255, hd = cl >> 6;
      float x0a, x0b, x1a, x1b, x2a, x2b;
      {
        uint32_t u;
        u = ld_pair(tq * 16 - 3, C_XBC + ch, st, 768); x0a = bflo(u); x0b = bfhi(u);
        u = ld_pair(tq * 16 - 2, C_XBC + ch, st, 768); x1a = bflo(u); x1b = bfhi(u);
        u = ld_pair(tq * 16 - 1, C_XBC + ch, st, 768); x2a = bflo(u); x2b = bfhi(u);
      }
      const float cslast = csL[63 * 4 + hd];
#pragma unroll 4
      for (int tt = 0; tt < 16; ++tt) {
        const int t = tq * 16 + tt;
        const uint32_t u = ld_pair(t, C_XBC + ch, st, 768);
        const float xa = bflo(u), xb = bfhi(u);
        float oa = siluf_(b0 + w00 * x0a + w10 * x1a + w20 * x2a + w30 * xa);
        float ob = siluf_(b1 + w01 * x0b + w11 * x1b + w21 * x2b + w31 * xb);
        if (t >= L) { oa = 0.f; ob = 0.f; }
        *(uint32_t*)(lds + sec * SLOT + t * CS_B + cl * 2) = pk2(oa, ob);
        if (sec == 0 && mode != 1) {
          const float sc = fexp(cslast - csL[t * 4 + hd]) * dtL[t * 4 + hd];
          *(uint32_t*)(lds + 3 * SLOT + t * CS_B + cl * 2) = pk2(oa * sc, ob * sc);
        }
        x0a = x1a; x0b = x1b; x1a = x2a; x1b = x2b; x2a = xa; x2b = xb;
      }
    }
    if (mode == 2 || (mode == 1 && c == 255)) {
      float* o = p.out + (mode == 2 ? O_SCS + (size_t)(layer * 8 + b) * 2304 : O_SCP + (size_t)(layer * 2 + b) * 2304);
      for (int idx = tid; idx < 2304; idx += 256) { const int j = idx / 768, cc = idx % 768; o[idx] = bf2f(proj[(size_t)(row0 + L - 3 + j) * PW + C_XBC + cc]); }
    }
  }
  __syncthreads();
  const int hd = w, grp = w >> 1;
  const char* Xs = lds, *Bm = lds + SLOT, *Cm = lds + 2 * SLOT, *Xw = lds + 3 * SLOT;
  if (mode != 1) {
    f32x16 sacc[4][2];
#pragma unroll
    for (int a = 0; a < 4; ++a) { sacc[a][0] = zero16(); sacc[a][1] = zero16(); }
#pragma unroll
    for (int ks = 0; ks < 4; ++ks) {
      bf16x8 xf[2];
      xf[0] = tr8(Xw, CS_B, ks * 16, hd * 64, lane); xf[1] = tr8(Xw, CS_B, ks * 16, hd * 64 + 32, lane);
#pragma unroll
      for (int nt = 0; nt < 4; ++nt) {
        const bf16x8 bfr = tr8(Bm, CS_B, ks * 16, grp * 128 + nt * 32, lane);
        sacc[nt][0] = mfma32(bfr, xf[0], sacc[nt][0]); sacc[nt][1] = mfma32(bfr, xf[1], sacc[nt][1]);
      }
    }
    const float dec = fexp(csL[63 * 4 + hd]);
    if (mode == 0) {
      bf16_t* S = (bf16_t*)(ws + W_SSDS) + ((size_t)(b * 256 + c) * 4 + hd) * 8192;
#pragma unroll
      for (int pt = 0; pt < 2; ++pt)
#pragma unroll
        for (int nt = 0; nt < 4; ++nt)
#pragma unroll
          for (int g = 0; g < 4; ++g) {
            u32x2 pk; pk[0] = pk2(sacc[nt][pt][4 * g], sacc[nt][pt][4 * g + 1]); pk[1] = pk2(sacc[nt][pt][4 * g + 2], sacc[nt][pt][4 * g + 3]);
            *(u32x2*)(S + (size_t)(pt * 32 + lr) * 128 + nt * 32 + 8 * g + 4 * hh) = pk;
          }
      if (lane == 0) ((float*)(ws + W_SSDDEC))[(size_t)(b * 256 + c) * 4 + hd] = dec;
    } else {
      const float* h0 = p.in[7] + ((size_t)(layer * 8 + b) * 4 + hd) * 8192;
      float* ho = p.out + O_SHS + ((size_t)(layer * 8 + b) * 4 + hd) * 8192;
#pragma unroll
      for (int pt = 0; pt < 2; ++pt)
#pragma unroll
        for (int nt = 0; nt < 4; ++nt)
#pragma unroll
          for (int g = 0; g < 4; ++g) {
            const size_t o = (size_t)(pt * 32 + lr) * 128 + nt * 32 + 8 * g + 4 * hh;
            f32x4 v = *(const f32x4*)(h0 + o);
            v[0] = dec * v[0] + sacc[nt][pt][4 * g]; v[1] = dec * v[1] + sacc[nt][pt][4 * g + 1]; v[2] = dec * v[2] + sacc[nt][pt][4 * g + 2]; v[3] = dec * v[3] + sacc[nt][pt][4 * g + 3];
            *(f32x4*)(ho + o) = v;
          }
    }
  }
  if (mode != 0) {
    f32x16 G[2][2];
    f32x16 YI[2][2];
#pragma unroll
    for (int a = 0; a < 2; ++a) { G[a][0] = zero16(); G[a][1] = zero16(); YI[a][0] = zero16(); YI[a][1] = zero16(); }
    const bf16_t* hst = (const bf16_t*)(ws + W_SSDS) + ((size_t)(b * 256 + c) * 4 + hd) * 8192;
    const float* h0 = p.in[7] + ((size_t)(layer * 8 + b) * 4 + hd) * 8192;
#pragma unroll
    for (int ks = 0; ks < 8; ++ks) {
      bf16x8 cf[2], bfr[2], hf[2];
#pragma unroll
      for (int a = 0; a < 2; ++a) {
        cf[a] = lds_read8(Cm + (a * 32 + lr) * CS_B + (grp * 128 + ks * 16 + hh * 8) * 2);
        bfr[a] = lds_read8(Bm + (a * 32 + lr) * CS_B + (grp * 128 + ks * 16 + hh * 8) * 2);
        const size_t ho = (size_t)(a * 32 + lr) * 128 + ks * 16 + hh * 8;
        if (mode == 1) hf[a] = *(const bf16x8*)(hst + ho);
        else { const f32x4 u0 = *(const f32x4*)(h0 + ho), u1 = *(const f32x4*)(h0 + ho + 4); hf[a] = pack8(u0[0], u0[1], u0[2], u0[3], u1[0], u1[1], u1[2], u1[3]); }
      }
#pragma unroll
      for (int a = 0; a < 2; ++a)
#pragma unroll
        for (int it = 0; it < 2; ++it) { G[a][it] = mfma32(bfr[a], cf[it], G[a][it]); YI[a][it] = mfma32(hf[a], cf[it], YI[a][it]); }
    }
    bf16x8 mf[2][4];
#pragma unroll
    for (int it = 0; it < 2; ++it) {
      const int i = it * 32 + lr;
      const float csi = csL[i * 4 + hd];
#pragma unroll
      for (int jt = 0; jt < 2; ++jt) {
        float v[16];
#pragma unroll
        for (int r = 0; r < 16; ++r) {
          const int j = jt * 32 + 8 * (r >> 2) + 4 * hh + (r & 3);
          const float e = j <= i ? fexp(csi - csL[j * 4 + hd]) * dtL[j * 4 + hd] : 0.f;
          v[r] = G[jt][it][r] * e;
        }
        mf[it][jt * 2 + 0] = pack8(v[0], v[1], v[2], v[3], v[4], v[5], v[6], v[7]);
        mf[it][jt * 2 + 1] = pack8(v[8], v[9], v[10], v[11], v[12], v[13], v[14], v[15]);
      }
    }
    f32x16 Y[2][2];
#pragma unroll
    for (int a = 0; a < 2; ++a) { Y[a][0] = zero16(); Y[a][1] = zero16(); }
#pragma unroll
    for (int ks = 0; ks < 4; ++ks) {
#pragma unroll
      for (int pt = 0; pt < 2; ++pt) {
        const bf16x8 xf = tr8(Xs, CS_B, ks * 16, hd * 64 + pt * 32, lane);
        Y[pt][0] = mfma32(xf, mf[0][ks], Y[pt][0]); Y[pt][1] = mfma32(xf, mf[1][ks], Y[pt][1]);
      }
    }
    const float Dh = p.in[21][layer * 4 + hd];
    float ssq2[2];
#pragma unroll
    for (int it = 0; it < 2; ++it) {
      const int i = it * 32 + lr;
      const int ic = i < L ? i : L - 1;
      const float ecs = fexp(csL[i * 4 + hd]);
      float s = 0.f;
#pragma unroll
      for (int pt = 0; pt < 2; ++pt)
#pragma unroll
        for (int g = 0; g < 4; ++g) {
          const int pp = pt * 32 + 8 * g + 4 * hh;
          const u32x2 xv = *(const u32x2*)(Xs + i * CS_B + (hd * 64 + pp) * 2);
          const u32x2 zv = *(const u32x2*)(proj + (size_t)(row0 + ic) * PW + C_Z + hd * 64 + pp);
          float y0 = Y[pt][it][4 * g] + ecs * YI[pt][it][4 * g] + Dh * bflo(xv[0]);
          float y1 = Y[pt][it][4 * g + 1] + ecs * YI[pt][it][4 * g + 1] + Dh * bfhi(xv[0]);
          float y2 = Y[pt][it][4 * g + 2] + ecs * YI[pt][it][4 * g + 2] + Dh * bflo(xv[1]);
          float y3 = Y[pt][it][4 * g + 3] + ecs * YI[pt][it][4 * g + 3] + Dh * bfhi(xv[1]);
          y0 *= siluf_(bflo(zv[0])); y1 *= siluf_(bfhi(zv[0])); y2 *= siluf_(bflo(zv[1])); y3 *= siluf_(bfhi(zv[1]));
          Y[pt][it][4 * g] = y0; Y[pt][it][4 * g + 1] = y1; Y[pt][it][4 * g + 2] = y2; Y[pt][it][4 * g + 3] = y3;
          s += y0 * y0 + y1 * y1 + y2 * y2 + y3 * y3;
        }
      s += shx(s, 32, lane);
      ssq2[it] = s;
      if (hh == 0) red[hd * 64 + i] = s;
    }
    __syncthreads();
    const float* ng = p.in[22] + layer * 256 + hd * 64;
#pragma unroll
    for (int it = 0; it < 2; ++it) {
      const int i = it * 32 + lr;
      const float tot = red[(grp * 2) * 64 + i] + red[(grp * 2 + 1) * 64 + i];
      const float rs = rsqrtf(tot * (1.f / 128.f) + EPS);
      if (i < L) {
#pragma unroll
        for (int pt = 0; pt < 2; ++pt)
#pragma unroll
          for (int g = 0; g < 4; ++g) {
            const int pp = pt * 32 + 8 * g + 4 * hh;
            const f32x4 gv = *(const f32x4*)(ng + pp);
            u32x2 pk; pk[0] = pk2(Y[pt][it][4 * g] * rs * gv[0], Y[pt][it][4 * g + 1] * rs * gv[1]); pk[1] = pk2(Y[pt][it][4 * g + 2] * rs * gv[2], Y[pt][it][4 * g + 3] * rs * gv[3]);
            *(u32x2*)(mixed + (size_t)(row0 + i) * DM + 256 + hd * 64 + pp) = pk;
          }
      }
    }
    (void)ssq2;
  }
  __syncthreads();
}

DEV void ssd_scan_unit(CParams& p, int layer, int su, const int swave) {
  const int gid = su * 256 + ltid();
  const int b = gid >> 12, rem = gid & 4095, h = rem >> 10, pn = rem & 1023;
  bf16_t* S = (bf16_t*)(p.ws + W_SSDS) + ((size_t)(b * 256) * 4 + h) * 8192 + (size_t)pn * 8;
  const float* dec = (const float*)(p.ws + W_SSDDEC) + (size_t)(b * 256) * 4 + h;
  float hs[8];
#pragma unroll
  for (int i = 0; i < 8; ++i) hs[i] = 0.f;
  for (int cb = 0; cb < 256; cb += 16) {
    u32x4 sv[16]; float dv[16];
#pragma unroll
    for (int k = 0; k < 16; ++k) { sv[k] = *(const u32x4*)(S + (size_t)(cb + k) * 4 * 8192); dv[k] = dec[(size_t)(cb + k) * 4]; }
#pragma unroll
    for (int k = 0; k < 16; ++k) {
      u32x4 o; o[0] = pk2(hs[0], hs[1]); o[1] = pk2(hs[2], hs[3]); o[2] = pk2(hs[4], hs[5]); o[3] = pk2(hs[6], hs[7]);
      *(u32x4*)(S + (size_t)(cb + k) * 4 * 8192) = o;
#pragma unroll
      for (int i = 0; i < 4; ++i) { hs[2 * i] = dv[k] * hs[2 * i] + bflo(sv[k][i]); hs[2 * i + 1] = dv[k] * hs[2 * i + 1] + bfhi(sv[k][i]); }
    }
  }
  float* o = p.out + O_SHP + ((size_t)(layer * 2 + b) * 4 + h) * 8192 + (size_t)pn * 8;
  f32x4 o0, o1; o0[0] = hs[0]; o0[1] = hs[1]; o0[2] = hs[2]; o0[3] = hs[3]; o1[0] = hs[4]; o1[1] = hs[5]; o1[2] = hs[6]; o1[3] = hs[7];
  *(f32x4*)o = o0; *(f32x4*)(o + 4) = o1;
}
DEV void lru_scan_unit(CParams& p, int layer, int b, const int swave) {
  const int ch = ltid();
  const float* A = (const float*)(p.ws + W_LRUA) + (size_t)b * 256 * 256 + ch;
  float* B = (float*)(p.ws + W_LRUB) + (size_t)b * 256 * 256 + ch;
  float h = 0.f;
  for (int cb = 0; cb < 256; cb += 16) {
    float av[16], bv[16];
#pragma unroll
    for (int k = 0; k < 16; ++k) { av[k] = A[(size_t)(cb + k) * 256]; bv[k] = B[(size_t)(cb + k) * 256]; }
#pragma unroll
    for (int k = 0; k < 16; ++k) { B[(size_t)(cb + k) * 256] = h; h = av[k] * h + bv[k]; }
  }
  p.out[O_LHP + (size_t)(layer * 2 + b) * 256 + ch] = h;
}

constexpr int AK_B = 272, AV_B = 320;
constexpr int A_KT = 64 * AK_B, A_VT = 64 * AV_B;
constexpr int A_BUF = A_KT + A_VT;

template <bool SAMPLE>
DEV void attn_unit(CParams& p, int layer, int unit, float lam, float lam_init, char* lds, const int swave) {
  const int tid = ltid(), lane = tid & 63, w = __builtin_amdgcn_readfirstlane(tid >> 6), lr = lane & 31, hh = lane >> 5;
  char* ws = p.ws;
  const bf16_t* proj = (const bf16_t*)(ws + W_PROJ);
  constexpr bool sample = SAMPLE;
  int b, head, qb = 0, ntiles;
  if (sample) { b = unit >> 2; head = unit & 3; ntiles = 33; }
  else { const int u = unit - 32; qb = 127 - (u >> 3); b = (u >> 2) & 1; head = u & 3; ntiles = 2 * qb + 2; }
  const int my_tiles = sample ? (w == 0 ? 33 : 0) : (w < 2 ? ntiles - 1 : ntiles);
  int qrow;
  if (sample) qrow = TP + b * 16 + (lr < 16 ? lr : 15);
  else qrow = b * 16384 + qb * 128 + w * 32 + lr;
  bf16x8 qf[2][4];
#pragma unroll
  for (int br = 0; br < 2; ++br)
#pragma unroll
    for (int ks = 0; ks < 4; ++ks) qf[br][ks] = *(const bf16x8*)(proj + (size_t)qrow * PW + C_Q + head * 128 + br * 64 + ks * 16 + hh * 8);
  const int krow = tid >> 4, kch = tid & 15;
  u32x4 rk[4], rv[4];
  const unsigned voffP = (unsigned)(krow * PW + kch * 8) * 2u;
  const unsigned voffC = (unsigned)(krow * 512 + kch * 8) * 2u;
  auto kbase = [&](int t, int i, unsigned& voff, size_t& vdelta) -> const char* {
    if (sample && t < 32) { voff = voffC; vdelta = W_VC - W_KC; return ws + W_KC + ((size_t)(b * 2048 + t * 64 + 16 * i) * 512 + head * 128) * 2; }
    voff = voffP; vdelta = (size_t)(C_V - C_K) * 2;
    if (sample) return (const char*)proj + ((size_t)(TP + b * 16) * PW + C_K + head * 128) * 2;
    return (const char*)proj + ((size_t)(b * 16384 + t * 64 + 16 * i) * PW + C_K + head * 128) * 2;
  };
  auto gloadK = [&](int t) {
#pragma unroll
    for (int i = 0; i < 4; ++i) { unsigned voff; size_t vd; const char* kb = kbase(t, i, voff, vd); rk[i] = *(const u32x4*)(kb + voff); }
  };
  auto gloadV = [&](int t) {
#pragma unroll
    for (int i = 0; i < 4; ++i) { unsigned voff; size_t vd; const char* kb = kbase(t, i, voff, vd); rv[i] = *(const u32x4*)(kb + vd + voff); }
  };
  auto lwrite = [&](int buf) {
    char* ks_ = lds + buf * A_BUF; char* vs_ = ks_ + A_KT;
#pragma unroll
    for (int i = 0; i < 4; ++i) {
      const int r = krow + 16 * i;
      *(u32x4*)(ks_ + r * AK_B + kch * 16) = rk[i];
      *(u32x4*)(vs_ + r * AV_B + kch * 16) = rv[i];
    }
  };
  f32x16 O1[4], O2[4];
#pragma unroll
  for (int e = 0; e < 4; ++e) { O1[e] = zero16(); O2[e] = zero16(); }
  float ls[2] = {0.f, 0.f};
  const float cexp = 0.125f * 1.4426950408889634f;
  gloadK(0); gloadV(0); lwrite(0); __syncthreads();
  float nmc[2] = {0.f, 0.f};
  if (my_tiles > 0) {
#pragma unroll
    for (int br = 0; br < 2; ++br) {
      f32x16 S0 = zero16(), S1 = zero16();
#pragma unroll
      for (int ks = 0; ks < 4; ++ks) {
        const bf16x8 k0 = lds_read8(lds + lr * AK_B + (br * 64 + ks * 16 + hh * 8) * 2);
        const bf16x8 k1 = lds_read8(lds + (32 + lr) * AK_B + (br * 64 + ks * 16 + hh * 8) * 2);
        S0 = mfma32(k0, qf[br][ks], S0); S1 = mfma32(k1, qf[br][ks], S1);
      }
      float m = S0[0];
#pragma unroll
      for (int r = 1; r < 16; ++r) m = fmaxf(m, S0[r]);
#pragma unroll
      for (int r = 0; r < 16; ++r) m = fmaxf(m, S1[r]);
      m = fmaxf(m, shx(m, 32, lane));
      nmc[br] = -m * cexp;
    }
  }
  for (int t = 0; t < ntiles; ++t) {
    const int tn = SAMPLE ? t + 1 : (t + 1 < ntiles ? t + 1 : t);
    if (!SAMPLE || t + 1 < ntiles) gloadK(tn);
    if (t < my_tiles) {
      const char* Ks = lds + (t & 1) * A_BUF; const char* Vs = Ks + A_KT;
      bf16x8 pf[2][4];
      f32x16 S0, S1;
      auto qk = [&](int br) {
        const f32x16 zc = {0.f, 0.f, 0.f, 0.f, 0.f, 0.f, 0.f, 0.f, 0.f, 0.f, 0.f, 0.f, 0.f, 0.f, 0.f, 0.f};
#pragma unroll
        for (int ks = 0; ks < 4; ++ks) {
          const bf16x8 k0 = lds_read8(Ks + lr * AK_B + (br * 64 + ks * 16 + hh * 8) * 2);
          const bf16x8 k1 = lds_read8(Ks + (32 + lr) * AK_B + (br * 64 + ks * 16 + hh * 8) * 2);
          S0 = mfma32(k0, qf[br][ks], ks == 0 ? zc : S0); S1 = mfma32(k1, qf[br][ks], ks == 0 ? zc : S1);
        }
        if (sample && t == 32) {
#pragma unroll
          for (int r = 0; r < 16; ++r) { if (r >= 8) S0[r] = -1e30f; S1[r] = -1e30f; }
        }
      };
      auto sm8 = [&](const f32x16& Sx, int r0, float nm, float& lsum) -> bf16x8 {
        f32x2 c2; c2[0] = cexp; c2[1] = cexp;
        f32x2 nm2; nm2[0] = nm; nm2[1] = nm;
        union { u32x4 u; bf16x8 b; } x;
        f32x2 sum2; sum2[0] = 0.f; sum2[1] = 0.f;
#pragma unroll
        for (int r = 0; r < 8; r += 2) {
          f32x2 v; v[0] = Sx[r0 + r]; v[1] = Sx[r0 + r + 1];
          v = v * c2 + nm2;
          f32x2 ex; ex[0] = __builtin_amdgcn_exp2f(v[0]); ex[1] = __builtin_amdgcn_exp2f(v[1]);
          sum2 += ex;
          x.u[r >> 1] = pk2(ex[0], ex[1]);
        }
        lsum += sum2[0] + sum2[1];
        return x.b;
      };
      qk(0);
      pf[0][0] = sm8(S0, 0, nmc[0], ls[0]); pf[0][1] = sm8(S0, 8, nmc[0], ls[0]);
      pf[0][2] = sm8(S1, 0, nmc[0], ls[0]); pf[0][3] = sm8(S1, 8, nmc[0], ls[0]);
      qk(1);
      if (!SAMPLE || t + 1 < ntiles) gloadV(tn);
#pragma unroll
      for (int sl = 0; sl < 4; ++sl) {
#pragma unroll
        for (int e = 0; e < 4; ++e) {
          const bf16x8 vf = tr8(Vs, AV_B, sl * 16, e * 32, lane);
          O1[e] = mfma32(vf, pf[0][sl], O1[e]);
        }
        pf[1][sl] = sm8(sl < 2 ? S0 : S1, (sl & 1) * 8, nmc[1], ls[1]);
      }
#pragma unroll
      for (int sl = 0; sl < 4; ++sl)
#pragma unroll
        for (int e = 0; e < 4; ++e) {
          const bf16x8 vf = tr8(Vs, AV_B, sl * 16, e * 32, lane);
          O2[e] = mfma32(vf, pf[1][sl], O2[e]);
        }
    }
    if (t >= my_tiles && (!SAMPLE || t + 1 < ntiles)) gloadV(tn);
    if (!SAMPLE || t + 1 < ntiles) lwrite((t + 1) & 1);
    __syncthreads();
  }
  if (my_tiles > 0) {
    const float l1 = ls[0] + shx(ls[0], 32, lane), l2 = ls[1] + shx(ls[1], 32, lane);
    const float i1 = 1.f / l1, i2 = lam / l2;
    float s = 0.f;
#pragma unroll
    for (int e = 0; e < 4; ++e)
#pragma unroll
      for (int r = 0; r < 16; ++r) { const float o = O1[e][r] * i1 - O2[e][r] * i2; O1[e][r] = o; s += o * o; }
    s += shx(s, 32, lane);
    const float rs = rsqrtf(s * (1.f / 128.f) + EPS) * (1.f - lam_init);
    const float* g = p.in[24] + layer * 128;
    const bool valid = !sample || lr < 16;
    if (valid) {
      bf16_t* orow = (bf16_t*)(ws + W_MIX) + (size_t)qrow * DM + 512 + head * 128;
#pragma unroll
      for (int e = 0; e < 4; ++e)
#pragma unroll
        for (int gq = 0; gq < 4; ++gq) {
          const int ee = e * 32 + 8 * gq + 4 * hh;
          const f32x4 gv = *(const f32x4*)(g + ee);
          u32x2 pk; pk[0] = pk2(O1[e][4 * gq] * rs * gv[0], O1[e][4 * gq + 1] * rs * gv[1]); pk[1] = pk2(O1[e][4 * gq + 2] * rs * gv[2], O1[e][4 * gq + 3] * rs * gv[3]);
          *(u32x2*)(orow + ee) = pk;
        }
    }
  }
}

DEV void final_norm_phase(CParams& p, int vb, int nb, const int swave) {
  const int lane = ltid() & 63, w = ltid() >> 6;
  const float* ssq = (const float*)(p.ws + W_SSQ);
  const float* g = p.in[29];
  for (int m = vb * 4 + w; m < MTOK; m += nb * 4) {
    const float rs = rscale_of(ssq, m);
    float* row = p.out + (size_t)m * DM;
#pragma unroll
    for (int i = 0; i < 4; ++i) {
      const int c = i * 256 + lane * 4;
      f32x4 v = *(const f32x4*)(row + c); const f32x4 gv = *(const f32x4*)(g + c);
      v[0] *= rs * gv[0]; v[1] *= rs * gv[1]; v[2] *= rs * gv[2]; v[3] *= rs * gv[3];
      *(f32x4*)(row + c) = v;
    }
  }
}

struct LamInit { float v[4]; };

DEV void grid_barrier(unsigned* bar, unsigned target, const int swave) {
  asm volatile("s_waitcnt vmcnt(0)" ::: "memory");
  __syncthreads();
  if (ltid() == 0) {
    __builtin_amdgcn_fence(__ATOMIC_RELEASE, "agent");
    asm volatile("s_waitcnt vmcnt(0)" ::: "memory");
    __hip_atomic_fetch_add(bar, 1u, __ATOMIC_RELAXED, __HIP_MEMORY_SCOPE_AGENT);
    while (__hip_atomic_load(bar, __ATOMIC_RELAXED, __HIP_MEMORY_SCOPE_AGENT) < target) __builtin_amdgcn_s_sleep(2);
    __builtin_amdgcn_fence(__ATOMIC_ACQUIRE, "agent");
    asm volatile("s_waitcnt vmcnt(0)" ::: "memory");
  }
  __syncthreads();
}

DEV CParams* get_params() {
  CParams* q = (CParams*)__builtin_amdgcn_kernarg_segment_ptr();
  asm volatile("" : "+s"(q));
  return q;
}

__global__ void __launch_bounds__(256) fwd_megakernel(Params p_unused, LamInit li) {
  extern __shared__ __attribute__((aligned(16))) char lds[];
  cg::grid_group grid = cg::this_grid();
  const int swave = __builtin_amdgcn_readfirstlane((int)(threadIdx.x >> 6));
  const int nb = gridDim.x;
  const int vb = (nb % 8 == 0) ? (blockIdx.x % 8) * (nb / 8) + blockIdx.x / 8 : blockIdx.x;
  __shared__ int s_unit;
  {
    CParams& p = *get_params();
    prologue_phase(p, lds, vb, nb, swave);
    grid_barrier((unsigned*)(p.ws + W_CTR) + 640, (unsigned)nb, swave);
    if (nb == 0x7fffffff) grid.sync();
  }

  for (int lp = 0; lp < DEPTH * 7; ++lp) {
    const int layer = lp / 7, ph = lp % 7;
    CParams& p = *get_params();
    char* ws = p.ws;
    if (ph == 0) {
      for (int rep = 0; rep < PROBE_GEMM; ++rep)
      gemm_phase<EPI_IN>(p, layer, (const bf16_t*)(ws + W_XBF), DM, (const bf16_t*)(ws + W_WTIN) + (size_t)layer * NIN * DM, DM, NIN / 256, lds, vb, nb, swave);
      if (nb == 256) { for (int u = vb - 128; u >= 0 && u < 512; u += 128) cache_conv_unit(p, layer, u, swave); }
      else { for (int u = vb; u < 512; u += nb) cache_conv_unit(p, layer, u, swave); }
    } else if (ph == 1 || ph == 3) {
      for (int rep = 0; rep < PROBE_CHUNK; ++rep)
      for (int u = vb; u < 512; u += nb) chunk_unit(p, layer, ph == 1 ? 0 : 1, u >> 8, u & 255, lds, swave);
    } else if (ph == 2) {
      const float* lv = p.in[23] + layer * 256;
      float d1 = 0.f, d2 = 0.f;
      const int lane = ltid() & 63;
      { const int l6 = lane; d1 = lv[l6] * lv[64 + l6]; d2 = lv[128 + l6] * lv[192 + l6]; }
#pragma unroll
      for (int o = 32; o >= 1; o >>= 1) { d1 += shx(d1, o, lane); d2 += shx(d2, o, lane); }
      const float lam = fexp(d1) - fexp(d2) + li.v[layer];
      constexpr int NSCAN = 42, NATT = 32 + 1024;
      for (int rep = 0; rep < PROBE_ATT; ++rep)
      for (;;) {
        __syncthreads();
        if (ltid() == 0) s_unit = (int)atomicAdd((unsigned*)(ws + W_CTR) + layer * 16 + rep * 4, 1u);
        __syncthreads();
        const int u = __builtin_amdgcn_readfirstlane(s_unit) + (rep ? NSCAN : 0);
        if (u >= NSCAN + NATT) break;
        if (u < 32) ssd_scan_unit(p, layer, u, swave);
        else if (u < 34) lru_scan_unit(p, layer, u - 32, swave);
        else if (u < 42) chunk_unit(p, layer, 2, u - 34, 0, lds, swave);
        else if (u - NSCAN < 32) attn_unit<true>(p, layer, u - NSCAN, lam, li.v[layer], lds, swave);
        else attn_unit<false>(p, layer, u - NSCAN, lam, li.v[layer], lds, swave);
      }
    } else if (ph == 4 || ph == 6) {
      const bf16_t* A = (const bf16_t*)(ws + (ph == 4 ? W_MIX : W_U));
      const bf16_t* Bt = ph == 4 ? (const bf16_t*)(ws + W_WTOUT) + (size_t)layer * DM * DM : (const bf16_t*)(ws + W_WTDN) + (size_t)layer * DM * DFF;
      const int K = ph == 4 ? DM : DFF;
      gemm_phase<EPI_RES>(p, layer, A, K, Bt, K, DM / 256, lds, vb, nb, swave);
    } else {
      for (int rep = 0; rep < PROBE_GEMM; ++rep)
      gemm_phase<EPI_UP>(p, layer, (const bf16_t*)(ws + W_XBF), DM, (const bf16_t*)(ws + W_WTUP) + (size_t)layer * DFF * DM, DM, DFF / 256, lds, vb, nb, swave);
    }
    grid_barrier((unsigned*)(ws + W_CTR) + 512, (unsigned)(lp + 1) * (unsigned)nb, swave);
  }
  {
    CParams& p = *get_params();
    final_norm_phase(p, vb, nb, swave);
  }
}

extern "C" void kernel_launch(void* const* d_in, const int* in_sizes, int n_in, void* d_out, int out_size, void* d_ws, size_t ws_size, hipStream_t stream) {
  static int grid_blocks = 0;
  if (!grid_blocks) {
    int dev = 0, cus = 0, per_cu = 0;
    (void)hipGetDevice(&dev);
    (void)hipDeviceGetAttribute(&cus, hipDeviceAttributeMultiprocessorCount, dev);
    (void)hipFuncSetAttribute((const void*)fwd_megakernel, hipFuncAttributeMaxDynamicSharedMemorySize, LDS_BYTES);
    (void)hipOccupancyMaxActiveBlocksPerMultiprocessor(&per_cu, fwd_megakernel, 256, LDS_BYTES);
    if (per_cu < 1) per_cu = 1;
    if (per_cu > 1) per_cu = 1;
    grid_blocks = cus * per_cu;
  }
  Params p;
  memset(&p, 0, sizeof(p));
  for (int i = 0; i < 30; ++i) p.in[i] = (const float*)d_in[i];
  p.out = (float*)d_out;
  p.ws = (char*)d_ws;
  LamInit li;
  for (int l = 0; l < 4; ++l) li.v[l] = (float)(0.8 - 0.6 * exp(-0.3 * (double)l));
  void* args[] = {&p, &li};
  (void)hipMemsetAsync((char*)d_ws + W_CTR, 0, 4096, stream);
  hipError_t e = hipLaunchCooperativeKernel((void*)fwd_megakernel, dim3(grid_blocks), dim3(256), args, LDS_BYTES, stream);
  if (e != hipSuccess) fprintf(stderr, "cooperative launch failed: %s (grid %d)\n", hipGetErrorString(e), grid_blocks);
}
```
